# Optimizing an MI355X kernel written in HIP

```python
import jax, jax.numpy as jnp
from jax import lax
import numpy as np

D_MODEL = 1024
BATCH = 8
SEQ = 4096
DEPTH = 1

HEAD_DIM = 64
DIL_PAIRS = ((128, 1), (512, 4), (2048, 16))
DIL_HEADS_PER_GROUP = 4
DIL_HEADS = DIL_HEADS_PER_GROUP * len(DIL_PAIRS)
DIL_WIDTH = DIL_HEADS * HEAD_DIM
DIL_OUT_WIDTH = DIL_HEADS_PER_GROUP * HEAD_DIM
SWA_WINDOW = 128
SWA_Q_HEADS = 8
SWA_KV_HEADS = 2
SWA_Q_WIDTH = SWA_Q_HEADS * HEAD_DIM
SWA_KV_WIDTH = SWA_KV_HEADS * HEAD_DIM
ROPE_THETA = 500000.0
ROPE_DIM = HEAD_DIM // 4
D_FF = 4 * D_MODEL
BLOCK = 128
EPS = 1e-6
NEG = -1e30
IN_SIZES = (DIL_WIDTH, DIL_WIDTH, DIL_WIDTH, SWA_Q_WIDTH, SWA_KV_WIDTH, SWA_KV_WIDTH, D_MODEL, D_MODEL)
IN_WIDTH = sum(IN_SIZES)

kernel_name = "hybrid_dilated_swa_sink_gated_block"


def rmsnorm(x, g):
    xf = x.astype(jnp.float32)
    y = xf * lax.rsqrt(jnp.mean(xf * xf, axis=-1, keepdims=True) + EPS)
    return (y * g.astype(jnp.float32)).astype(x.dtype)


def rope_tables(positions):
    inv_freq = ROPE_THETA ** (-jnp.arange(0, ROPE_DIM, 2, dtype=jnp.float32) / ROPE_DIM)
    ang = positions.astype(jnp.float32)[..., None] * inv_freq
    return jnp.cos(ang)[:, :, None, :], jnp.sin(ang)[:, :, None, :]


def apply_partial_rope(x, cos, sin):
    half = ROPE_DIM // 2
    xr = x[..., :ROPE_DIM].astype(jnp.float32)
    x1, x2 = xr[..., :half], xr[..., half:]
    rot = jnp.concatenate([x1 * cos - x2 * sin, x2 * cos + x1 * sin], axis=-1).astype(x.dtype)
    return jnp.concatenate([rot, x[..., ROPE_DIM:]], axis=-1)


def banded_attention(q, k, v, max_dist, sinks=None):
    B, N, L, H, Dh = q.shape
    Hkv = k.shape[3]
    G = H // Hkv
    Lp = -(-L // BLOCK) * BLOCK
    pad = Lp - L
    if pad:
        cfg = ((0, 0), (0, 0), (0, pad), (0, 0), (0, 0))
        q, k, v = jnp.pad(q, cfg), jnp.pad(k, cfg), jnp.pad(v, cfg)
    nb = Lp // BLOCK
    qb = q.reshape(B, N, nb, BLOCK, Hkv, G, Dh).astype(jnp.float32)

    def band(t):
        tp = jnp.pad(t, ((0, 0), (0, 0), (BLOCK, 0), (0, 0), (0, 0)))
        tb = tp.reshape(B, N, nb + 1, BLOCK, Hkv, Dh)
        return jnp.concatenate([tb[:, :, :-1], tb[:, :, 1:]], axis=3)

    kb = band(k).astype(jnp.float32)
    vb = band(v).astype(jnp.float32)
    scale = 1.0 / np.sqrt(Dh).astype(np.float32)
    s = jnp.einsum('bnjqhgd,bnjkhd->bnjhgqk', qb, kb) * scale
    blk = jnp.arange(nb)[:, None, None]
    qpos = blk * BLOCK + jnp.arange(BLOCK)[None, :, None]
    kpos = (blk - 1) * BLOCK + jnp.arange(2 * BLOCK)[None, None, :]
    dist = qpos - kpos
    mask = (dist >= 0) & (dist <= max_dist) & (kpos >= 0)
    s = jnp.where(mask[:, None, None, :, :], s, jnp.float32(NEG))
    m = jnp.max(s, axis=-1, keepdims=True)
    if sinks is not None:
        sk = sinks.astype(jnp.float32).reshape(Hkv, G)[:, :, None, None]
        m = jnp.maximum(m, sk)
        p = jnp.exp(s - m)
        denom = jnp.sum(p, axis=-1, keepdims=True) + jnp.exp(sk - m)
    else:
        p = jnp.exp(s - m)
        denom = jnp.sum(p, axis=-1, keepdims=True)
    o = jnp.einsum('bnjhgqk,bnjkhd->bnjqhgd', p / denom, vb)
    o = o.reshape(B, N, Lp, H, Dh)[:, :, :L].astype(v.dtype)
    lse = (m + jnp.log(denom))[..., 0]
    lse = lse.transpose(0, 1, 2, 5, 3, 4).reshape(B, N, Lp, H)[:, :, :L]
    return o, lse


def dilated_attention(q, k, v):
    B, S, _, Dh = q.shape
    outs, lses = [], []
    for g, (w, d) in enumerate(DIL_PAIRS):
        lo, hi = g * DIL_HEADS_PER_GROUP, (g + 1) * DIL_HEADS_PER_GROUP

        def strided(t):
            return t[:, :, lo:hi].reshape(B, S // d, d, DIL_HEADS_PER_GROUP, Dh).transpose(0, 2, 1, 3, 4)

        o, lse = banded_attention(strided(q), strided(k), strided(v), w // d)
        outs.append(o.transpose(0, 2, 1, 3, 4).reshape(B, S, DIL_HEADS_PER_GROUP, Dh))
        lses.append(lse.transpose(0, 2, 1, 3).reshape(B, S, DIL_HEADS_PER_GROUP))
    alpha = jax.nn.softmax(jnp.stack(lses, axis=0), axis=0)
    o = jnp.sum(alpha[..., None] * jnp.stack(outs, axis=0).astype(jnp.float32), axis=0)
    return o.reshape(B, S, DIL_OUT_WIDTH).astype(q.dtype)


def setup_inputs(seed: int = 0) -> dict:
    key = jax.random.key(seed)
    ks = jax.random.split(key, 16)
    f32 = jnp.float32

    def w(k, shape, fan_in):
        return jax.random.normal(k, shape, f32) * (fan_in ** -0.5)

    def gain(k, shape):
        return 1.0 + 0.02 * jax.random.normal(k, shape, f32)

    x = jax.random.normal(ks[0], (BATCH, SEQ, D_MODEL), f32)
    offset = jax.random.randint(ks[1], (BATCH, 1), 0, 1024, dtype=jnp.int32)
    positions = (offset + jnp.arange(SEQ, dtype=jnp.int32)[None, :]).astype(jnp.int32)
    return {
        "x": x,
        "positions": positions,
        "ln1_g": gain(ks[2], (DEPTH, D_MODEL)),
        "w_in": w(ks[3], (DEPTH, D_MODEL, IN_WIDTH), D_MODEL),
        "q_norm_a": gain(ks[4], (DEPTH, HEAD_DIM)),
        "k_norm_a": gain(ks[5], (DEPTH, HEAD_DIM)),
        "q_norm_b": gain(ks[6], (DEPTH, HEAD_DIM)),
        "k_norm_b": gain(ks[7], (DEPTH, HEAD_DIM)),
        "sinks": 0.5 * jax.random.normal(ks[8], (DEPTH, SWA_Q_HEADS), f32),
        "w_branch_a": w(ks[9], (DEPTH, DIL_OUT_WIDTH, D_MODEL), DIL_OUT_WIDTH),
        "w_branch_b": w(ks[10], (DEPTH, SWA_Q_WIDTH, D_MODEL), SWA_Q_WIDTH),
        "w_out": w(ks[11], (DEPTH, D_MODEL, D_MODEL), D_MODEL),
        "ln2_g": gain(ks[12], (DEPTH, D_MODEL)),
        "w_up": w(ks[13], (DEPTH, D_MODEL, D_FF), D_MODEL),
        "w_down": w(ks[14], (DEPTH, D_FF, D_MODEL), D_FF),
    }


def reference(x, positions, ln1_g, w_in, q_norm_a, k_norm_a, q_norm_b, k_norm_b, sinks,
              w_branch_a, w_branch_b, w_out, ln2_g, w_up, w_down):
    B, S, _ = x.shape
    cos, sin = rope_tables(positions)
    offsets = np.cumsum(np.array(IN_SIZES))[:-1].tolist()
    for l in range(DEPTH):
        h = rmsnorm(x, ln1_g[l])
        proj = h @ w_in[l]
        qa, ka, va, qb, kb, vb, ga, gb = jnp.split(proj, offsets, axis=-1)
        qa = apply_partial_rope(rmsnorm(qa.reshape(B, S, DIL_HEADS, HEAD_DIM), q_norm_a[l]), cos, sin)
        ka = apply_partial_rope(rmsnorm(ka.reshape(B, S, DIL_HEADS, HEAD_DIM), k_norm_a[l]), cos, sin)
        va = va.reshape(B, S, DIL_HEADS, HEAD_DIM)
        oa = dilated_attention(qa, ka, va)
        qb = apply_partial_rope(rmsnorm(qb.reshape(B, S, SWA_Q_HEADS, HEAD_DIM), q_norm_b[l]), cos, sin)
        kb = apply_partial_rope(rmsnorm(kb.reshape(B, S, SWA_KV_HEADS, HEAD_DIM), k_norm_b[l]), cos, sin)
        vb = vb.reshape(B, S, SWA_KV_HEADS, HEAD_DIM)
        ob, _ = banded_attention(qb[:, None], kb[:, None], vb[:, None], SWA_WINDOW - 1, sinks[l])
        ob = ob.reshape(B, S, SWA_Q_WIDTH)
        mix = jax.nn.sigmoid(ga) * (oa @ w_branch_a[l]) + jax.nn.sigmoid(gb) * (ob @ w_branch_b[l])
        x = x + mix @ w_out[l]
        h2 = rmsnorm(x, ln2_g[l])
        x = x + jnp.square(jax.nn.relu(h2 @ w_up[l])) @ w_down[l]
    return x
```

```cpp
#include <hip/hip_runtime.h>
#include <cstdio>
#include <cstdint>

namespace {
constexpr int D_MODEL = 1024, BATCH = 8, SEQ = 4096, HD = 64;
constexpr int DIL_W = 768, SWA_QW = 512, SWA_KVW = 128, D_FF = 4096, IN_W = 5120;
constexpr int OFF_QA = 0, OFF_KA = 768, OFF_VA = 1536, OFF_QB = 2304, OFF_KB = 2816, OFF_VB = 2944, OFF_GA = 3072, OFF_GB = 4096;
constexpr float EPS = 1e-6f;

__device__ __forceinline__ float wave_sum(float v) {
#pragma unroll
    for (int o = 1; o < 64; o <<= 1) v += __shfl_xor(v, o);
    return v;
}
__device__ __forceinline__ float wave_max(float v) {
#pragma unroll
    for (int o = 1; o < 64; o <<= 1) v = fmaxf(v, __shfl_xor(v, o));
    return v;
}

__global__ void rmsnorm_rows(const float* __restrict__ x, const float* __restrict__ g, float* __restrict__ out, int rows) {
    const int w = (blockIdx.x * blockDim.x + threadIdx.x) >> 6, lane = threadIdx.x & 63;
    if (w >= rows) return;
    const float* xr = x + (size_t)w * D_MODEL;
    float v[16]; float s = 0.f;
#pragma unroll
    for (int j = 0; j < 16; ++j) { v[j] = xr[lane + 64 * j]; s += v[j] * v[j]; }
    s = wave_sum(s);
    const float r = rsqrtf(s * (1.f / D_MODEL) + EPS);
#pragma unroll
    for (int j = 0; j < 16; ++j) out[(size_t)w * D_MODEL + lane + 64 * j] = v[j] * r * g[lane + 64 * j];
}

template <int EPI>
__global__ void __launch_bounds__(256) sgemm(const float* __restrict__ A, int lda, const float* __restrict__ B, int ldb, float* C, int ldc, int K, const float* R, int ldr) {
    __shared__ float As[16][68];
    __shared__ float Bs[16][68];
    const int tid = threadIdx.x, tx = tid & 15, ty = tid >> 4;
    const int m0 = blockIdx.y * 64, n0 = blockIdx.x * 64;
    float acc[4][4];
#pragma unroll
    for (int i = 0; i < 4; ++i)
#pragma unroll
        for (int j = 0; j < 4; ++j) acc[i][j] = 0.f;
    for (int k0 = 0; k0 < K; k0 += 16) {
        {
            const int r = tid >> 2, c4 = (tid & 3) * 4;
            const float4 v = *(const float4*)(A + (size_t)(m0 + r) * lda + k0 + c4);
            As[c4 + 0][r] = v.x; As[c4 + 1][r] = v.y; As[c4 + 2][r] = v.z; As[c4 + 3][r] = v.w;
        }
        {
            const int r = tid >> 4, c4 = (tid & 15) * 4;
            const float4 v = *(const float4*)(B + (size_t)(k0 + r) * ldb + n0 + c4);
            Bs[r][c4 + 0] = v.x; Bs[r][c4 + 1] = v.y; Bs[r][c4 + 2] = v.z; Bs[r][c4 + 3] = v.w;
        }
        __syncthreads();
#pragma unroll
        for (int k = 0; k < 16; ++k) {
            float a[4], b[4];
#pragma unroll
            for (int i = 0; i < 4; ++i) a[i] = As[k][ty * 4 + i];
#pragma unroll
            for (int j = 0; j < 4; ++j) b[j] = Bs[k][tx * 4 + j];
#pragma unroll
            for (int i = 0; i < 4; ++i)
#pragma unroll
                for (int j = 0; j < 4; ++j) acc[i][j] = fmaf(a[i], b[j], acc[i][j]);
        }
        __syncthreads();
    }
#pragma unroll
    for (int i = 0; i < 4; ++i)
#pragma unroll
        for (int j = 0; j < 4; ++j) {
            const int r = m0 + ty * 4 + i, c = n0 + tx * 4 + j;
            float v = acc[i][j];
            if (EPI == 1) v += R[(size_t)r * ldr + c];
            if (EPI == 2) { v = fmaxf(v, 0.f); v = v * v; }
            C[(size_t)r * ldc + c] = v;
        }
}

__global__ void qknorm_rope(float* proj, const int* __restrict__ pos, const float* __restrict__ qna, const float* __restrict__ kna,
                            const float* __restrict__ qnb, const float* __restrict__ knb) {
    const int w = (blockIdx.x * blockDim.x + threadIdx.x) >> 6, lane = threadIdx.x & 63;
    if (w >= SEQ * 34) return;
    const int t = w / 34, hh = w % 34;
    int col; const float* g;
    if (hh < 12) { col = OFF_QA + hh * 64; g = qna; }
    else if (hh < 24) { col = OFF_KA + (hh - 12) * 64; g = kna; }
    else if (hh < 32) { col = OFF_QB + (hh - 24) * 64; g = qnb; }
    else { col = OFF_KB + (hh - 32) * 64; g = knb; }
    float* p = proj + (size_t)t * IN_W + col;
    const float v = p[lane];
    const float s = wave_sum(v * v);
    float y = v * rsqrtf(s * (1.f / 64.f) + EPS) * g[lane];
    const int j = lane & 7;
    const float invf = powf(500000.0f, -(float)(2 * j) / 16.0f);
    const float ang = (float)pos[t] * invf;
    const float c = cosf(ang), sn = sinf(ang);
    const float other = __shfl_xor(y, 8);
    if (lane < 8) y = y * c - other * sn;
    else if (lane < 16) y = y * c + other * sn;
    p[lane] = y;
}

__global__ void attn_naive(const float* __restrict__ proj, float* __restrict__ o, int ldo, float* __restrict__ lse, int ldl,
                           int nheads, int qcol0, int kcol0, int vcol0, int kvdiv, int stride, int nkeys, const float* __restrict__ sinks) {
    const int w = (blockIdx.x * blockDim.x + threadIdx.x) >> 6, lane = threadIdx.x & 63;
    if (w >= SEQ * nheads) return;
    const int t = w / nheads, h = w % nheads;
    const float* q = proj + (size_t)t * IN_W + qcol0 + h * 64;
    const int kvh = h / kvdiv;
    float s[3]; float m = -1e30f;
#pragma unroll
    for (int i = 0; i < 3; ++i) {
        const int k = lane + 64 * i; s[i] = -1e30f;
        const int tk = t - stride * k;
        if (k < nkeys && tk >= 0) {
            const float* kp = proj + (size_t)tk * IN_W + kcol0 + kvh * 64;
            float acc = 0.f;
            for (int d = 0; d < 64; ++d) acc = fmaf(q[d], kp[d], acc);
            s[i] = acc * 0.125f;
        }
        m = fmaxf(m, s[i]);
    }
    m = wave_max(m);
    float sk = 0.f;
    if (sinks) { sk = sinks[h]; m = fmaxf(m, sk); }
    float p[3]; float den = 0.f;
#pragma unroll
    for (int i = 0; i < 3; ++i) { p[i] = (s[i] > -1e29f) ? expf(s[i] - m) : 0.f; den += p[i]; }
    den = wave_sum(den);
    if (sinks) den += expf(sk - m);
    float acc = 0.f;
#pragma unroll
    for (int i = 0; i < 3; ++i) {
        for (int kk = 0; kk < 64; ++kk) {
            const int k = kk + 64 * i;
            const int tk = t - stride * k;
            if (k >= nkeys || tk < 0) break;
            const float pk = __shfl(p[i], kk);
            acc = fmaf(pk, proj[(size_t)tk * IN_W + vcol0 + kvh * 64 + lane], acc);
        }
    }
    o[(size_t)t * ldo + h * 64 + lane] = acc / den;
    if (lse && lane == 0) lse[(size_t)t * ldl + h] = m + logf(den);
}

__global__ void combine_dil(const float* __restrict__ o3, const float* __restrict__ lse, float* __restrict__ oa) {
    const int idx = blockIdx.x * blockDim.x + threadIdx.x;
    if (idx >= SEQ * 256) return;
    const int t = idx >> 8, c = idx & 255, j = c >> 6, d = c & 63;
    float l[3], m = -1e30f;
#pragma unroll
    for (int g = 0; g < 3; ++g) { l[g] = lse[(size_t)t * 12 + 4 * g + j]; m = fmaxf(m, l[g]); }
    float e[3], den = 0.f;
#pragma unroll
    for (int g = 0; g < 3; ++g) { e[g] = expf(l[g] - m); den += e[g]; }
    float acc = 0.f;
#pragma unroll
    for (int g = 0; g < 3; ++g) acc += (e[g] / den) * o3[(size_t)t * 768 + (4 * g + j) * 64 + d];
    oa[idx] = acc;
}

__global__ void gate_merge(const float* __restrict__ proj, const float* __restrict__ brA, const float* __restrict__ brB, float* __restrict__ mix) {
    const int idx = blockIdx.x * blockDim.x + threadIdx.x;
    if (idx >= SEQ * D_MODEL) return;
    const int t = idx >> 10, c = idx & 1023;
    const float ga = proj[(size_t)t * IN_W + OFF_GA + c], gb = proj[(size_t)t * IN_W + OFF_GB + c];
    const float sa = 1.f / (1.f + expf(-ga)), sb = 1.f / (1.f + expf(-gb));
    mix[idx] = sa * brA[idx] + sb * brB[idx];
}
}

extern "C" void kernel_launch(void* const* d_in, const int* in_sizes, int n_in, void* d_out, int out_size, void* d_ws, size_t ws_size, hipStream_t stream) {
    const float* x = (const float*)d_in[0];
    const int* positions = (const int*)d_in[1];
    const float* ln1_g = (const float*)d_in[2];
    const float* w_in = (const float*)d_in[3];
    const float* qna = (const float*)d_in[4];
    const float* kna = (const float*)d_in[5];
    const float* qnb = (const float*)d_in[6];
    const float* knb = (const float*)d_in[7];
    const float* sinks = (const float*)d_in[8];
    const float* w_a = (const float*)d_in[9];
    const float* w_b = (const float*)d_in[10];
    const float* w_o = (const float*)d_in[11];
    const float* ln2_g = (const float*)d_in[12];
    const float* w_up = (const float*)d_in[13];
    const float* w_down = (const float*)d_in[14];
    float* out = (float*)d_out;
    float* ws = (float*)d_ws;
    size_t off = 0;
    auto take = [&](size_t n) { float* p = ws + off; off += n; return p; };
    float* h = take((size_t)SEQ * D_MODEL);
    float* proj = take((size_t)SEQ * IN_W);
    float* o3 = take((size_t)SEQ * 768);
    float* lse = take((size_t)SEQ * 12);
    float* ob = take((size_t)SEQ * 512);
    float* oa = take((size_t)SEQ * 256);
    float* brA = take((size_t)SEQ * D_MODEL);
    float* brB = take((size_t)SEQ * D_MODEL);
    float* mix = take((size_t)SEQ * D_MODEL);
    float* h2 = take((size_t)SEQ * D_MODEL);
    float* hid = take((size_t)SEQ * D_FF);
    if (off * 4 > ws_size) { fprintf(stderr, "ws too small\n"); return; }
    for (int b = 0; b < BATCH; ++b) {
        const float* xb = x + (size_t)b * SEQ * D_MODEL;
        float* outb = out + (size_t)b * SEQ * D_MODEL;
        const int* posb = positions + (size_t)b * SEQ;
        rmsnorm_rows<<<SEQ / 4, 256, 0, stream>>>(xb, ln1_g, h, SEQ);
        sgemm<0><<<dim3(IN_W / 64, SEQ / 64), 256, 0, stream>>>(h, D_MODEL, w_in, IN_W, proj, IN_W, D_MODEL, nullptr, 0);
        qknorm_rope<<<SEQ * 34 / 4, 256, 0, stream>>>(proj, posb, qna, kna, qnb, knb);
        const int dil[3] = {1, 4, 16};
        for (int g = 0; g < 3; ++g)
            attn_naive<<<SEQ * 4 / 4, 256, 0, stream>>>(proj, o3 + g * 256, 768, lse + g * 4, 12, 4, OFF_QA + g * 256, OFF_KA + g * 256, OFF_VA + g * 256, 1, dil[g], 129, nullptr);
        attn_naive<<<SEQ * 8 / 4, 256, 0, stream>>>(proj, ob, 512, nullptr, 0, 8, OFF_QB, OFF_KB, OFF_VB, 4, 1, 128, sinks);
        combine_dil<<<SEQ * 256 / 256, 256, 0, stream>>>(o3, lse, oa);
        sgemm<0><<<dim3(D_MODEL / 64, SEQ / 64), 256, 0, stream>>>(oa, 256, w_a, D_MODEL, brA, D_MODEL, 256, nullptr, 0);
        sgemm<0><<<dim3(D_MODEL / 64, SEQ / 64), 256, 0, stream>>>(ob, 512, w_b, D_MODEL, brB, D_MODEL, 512, nullptr, 0);
        gate_merge<<<SEQ * D_MODEL / 256, 256, 0, stream>>>(proj, brA, brB, mix);
        sgemm<1><<<dim3(D_MODEL / 64, SEQ / 64), 256, 0, stream>>>(mix, D_MODEL, w_o, D_MODEL, outb, D_MODEL, D_MODEL, xb, D_MODEL);
        rmsnorm_rows<<<SEQ / 4, 256, 0, stream>>>(outb, ln2_g, h2, SEQ);
        sgemm<2><<<dim3(D_FF / 64, SEQ / 64), 256, 0, stream>>>(h2, D_MODEL, w_up, D_FF, hid, D_FF, D_MODEL, nullptr, 0);
        sgemm<1><<<dim3(D_MODEL / 64, SEQ / 64), 256, 0, stream>>>(hid, D_FF, w_down, D_MODEL, outb, D_MODEL, D_FF, outb, D_MODEL);
    }
}
```

```cpp
#include <hip/hip_runtime.h>
#include <cstdio>
#include <cstdint>
namespace pg8 {
#define PG8_LAS __attribute__((address_space(3)))
typedef unsigned short bf16_t;
typedef short bf16x8 __attribute__((ext_vector_type(8)));
typedef float f32x4 __attribute__((ext_vector_type(4)));
typedef unsigned u32x4 __attribute__((ext_vector_type(4)));
constexpr int BM = 256, BK = 64, HALF = 128, HTB = HALF * BK * 2  , STAGE_BYTES = 8 * HTB, NXCD = 8, WGM = 8;

__host__ __device__ __forceinline__ int lds_byte(int r, int c) { const int st = (r >> 4) * 2 + (c >> 5), rr = r & 15, cc = c & 31, ob = rr * 64 + cc * 2; return st * 1024 + (ob ^ (((ob >> 9) & 1) << 5)); }
__host__ __device__ __forceinline__ void stage_rc(int b, int& R, int& C) { const int st = b / 1024, sb = b % 1024, swz = sb ^ (((sb >> 9) & 1) << 5); R = (st >> 1) * 16 + swz / 64; C = (st & 1) * 32 + (swz % 64) / 2; }
__host__ __device__ __forceinline__ int perm32(int rho) { const int n = rho >> 4, i = rho & 15; return 8 * (i >> 2) + 4 * n + (i & 3); }

struct Unit { int pm, pn; };
struct Gemm { const bf16_t* A; const bf16_t* Bt; int M, N, K; };

struct StaticOrder {
    int nM, nN, nwg, G, c;
    __host__ __device__ void init(int M, int N, int G_, int c_) { nM = M / BM; nN = N / BM; nwg = nM * nN; G = G_; c = c_; }
    __host__ __device__ bool next(int i, Unit& u) const {
        const long L = (long)i * G + c; if (L >= nwg) return false;
        int wgid = (int)L; { const int q = nwg / NXCD, r = nwg % NXCD, xcd = wgid % NXCD, off = wgid / NXCD; wgid = (xcd < r ? xcd * (q + 1) : r * (q + 1) + (xcd - r) * q) + off; }
        const int nig = WGM * nN, gid = wgid / nig, fm = gid * WGM, gsz = (nM - fm) < WGM ? (nM - fm) : WGM;
        u.pm = fm + ((wgid % nig) % gsz); u.pn = (wgid % nig) / gsz; return true;
    }
    __device__ __forceinline__ void a_ready(const Unit&) const {}
    __device__ __forceinline__ void done(const Unit&) const {}
};
__device__ __forceinline__ unsigned cvt_pk_bf16(float lo, float hi) { unsigned r; asm volatile("v_cvt_pk_bf16_f32 %0, %1, %2" : "=v"(r) : "v"(lo), "v"(hi)); return r; }
typedef unsigned u32x2 __attribute__((ext_vector_type(2)));
constexpr float C2 = 0.125f * 1.4426950408889634f;
__device__ __forceinline__ float sigmoid_f(float v) { return __builtin_amdgcn_rcpf(1.0f + __builtin_amdgcn_exp2f(-1.4426950408889634f * v)); }
__device__ __forceinline__ f32x4 bf2_to_f4(unsigned a, unsigned b) { f32x4 r; r[0] = __uint_as_float(a << 16); r[1] = __uint_as_float(a & 0xffff0000u); r[2] = __uint_as_float(b << 16); r[3] = __uint_as_float(b & 0xffff0000u); return r; }

struct EpiInProj {
    static constexpr bool PERM = true, AFTER_DRAIN = false;
    bf16_t *QA, *KA, *VA, *QB, *KB, *VB, *GA, *GB; const float* cs; const float *qna, *kna, *qnb, *knb;
    __device__ __forceinline__ void operator()(const f32x4 (&acc)[2][2][4][2], const Unit& u, int wr, int wc, int fr, int fq) const {
        const int pn = u.pn;
        bf16_t* base; int pitch, col, mode; const float* gain = qna; float scale = 1.f;
        if (pn < 3)        { base = QA; pitch = 768; col = (pn * 4 + wc) * 64; mode = 1; gain = qna; scale = C2; }
        else if (pn < 6)   { base = KA; pitch = 768; col = ((pn - 3) * 4 + wc) * 64; mode = 1; gain = kna; }
        else if (pn < 9)   { base = VA; pitch = 768; col = ((pn - 6) * 4 + wc) * 64; mode = 0; }
        else if (pn < 11)  { base = QB; pitch = 512; col = ((pn - 9) * 4 + wc) * 64; mode = 1; gain = qnb; scale = C2; }
        else if (pn == 11) { if (wc < 2) { base = KB; pitch = 128; col = wc * 64; mode = 1; gain = knb; } else { base = VB; pitch = 128; col = (wc - 2) * 64; mode = 0; } }
        else if (pn < 16)  { base = GA; pitch = 1024; col = (pn - 12) * 256 + wc * 64; mode = 2; }
        else               { base = GB; pitch = 1024; col = (pn - 16) * 256 + wc * 64; mode = 2; }
        const int row0 = u.pm * BM + wr * 64 + fr;
        if (mode == 1) {
            f32x4 g[2][2];
#pragma unroll
            for (int bj = 0; bj < 2; ++bj)
#pragma unroll
                for (int n = 0; n < 2; ++n) g[bj][n] = *(const f32x4*)(gain + 32 * bj + 8 * fq + 4 * n) * scale;
#pragma unroll
            for (int ai = 0; ai < 2; ++ai)
#pragma unroll
                for (int m = 0; m < 4; ++m) {
                    const int row = row0 + ai * HALF + m * 16;
                    const float* csr = cs + (size_t)row * 16;
                    const f32x4 c0 = *(const f32x4*)(csr), c1 = *(const f32x4*)(csr + 4), s0 = *(const f32x4*)(csr + 8), s1 = *(const f32x4*)(csr + 12);
                    float ss = 0.f;
#pragma unroll
                    for (int bj = 0; bj < 2; ++bj)
#pragma unroll
                        for (int n = 0; n < 2; ++n) { const f32x4 v = acc[ai][bj][m][n]; ss += (v[0] * v[0] + v[1] * v[1]) + (v[2] * v[2] + v[3] * v[3]); }
                    ss += __shfl_xor(ss, 16); ss += __shfl_xor(ss, 32);
                    const float rinv = rsqrtf(ss * (1.0f / 64.0f) + 1e-6f);
                    f32x4 y[2][2];
#pragma unroll
                    for (int bj = 0; bj < 2; ++bj)
#pragma unroll
                        for (int n = 0; n < 2; ++n) y[bj][n] = acc[ai][bj][m][n] * rinv * g[bj][n];
                    f32x4 p0, p1;
#pragma unroll
                    for (int i = 0; i < 4; ++i) { p0[i] = __shfl_xor(y[0][0][i], 16); p1[i] = __shfl_xor(y[0][1][i], 16); }
                    if (fq == 0) { y[0][0] = y[0][0] * c0 - p0 * s0; y[0][1] = y[0][1] * c1 - p1 * s1; }
                    else if (fq == 1) { y[0][0] = y[0][0] * c0 + p0 * s0; y[0][1] = y[0][1] * c1 + p1 * s1; }
                    bf16_t* rowp = base + (size_t)row * pitch + col + 8 * fq;
#pragma unroll
                    for (int bj = 0; bj < 2; ++bj) { u32x4 w; w.x = cvt_pk_bf16(y[bj][0][0], y[bj][0][1]); w.y = cvt_pk_bf16(y[bj][0][2], y[bj][0][3]); w.z = cvt_pk_bf16(y[bj][1][0], y[bj][1][1]); w.w = cvt_pk_bf16(y[bj][1][2], y[bj][1][3]);
                        *(u32x4*)(rowp + 32 * bj) = w; }
                }
        } else {
#pragma unroll
            for (int ai = 0; ai < 2; ++ai)
#pragma unroll
                for (int m = 0; m < 4; ++m) {
                    const int row = row0 + ai * HALF + m * 16;
                    bf16_t* rowp = base + (size_t)row * pitch + col + 8 * fq;
#pragma unroll
                    for (int bj = 0; bj < 2; ++bj) { f32x4 v0 = acc[ai][bj][m][0], v1 = acc[ai][bj][m][1];
                        if (mode == 2) {
#pragma unroll
                            for (int i = 0; i < 4; ++i) { v0[i] = sigmoid_f(v0[i]); v1[i] = sigmoid_f(v1[i]); } }
                        u32x4 w; w.x = cvt_pk_bf16(v0[0], v0[1]); w.y = cvt_pk_bf16(v0[2], v0[3]); w.z = cvt_pk_bf16(v1[0], v1[1]); w.w = cvt_pk_bf16(v1[2], v1[3]);
                        *(u32x4*)(rowp + 32 * bj) = w; }
                }
        }
    }
};
struct EpiMergeA {
    static constexpr bool PERM = true, AFTER_DRAIN = false;
    const bf16_t* G; float* T;
    __device__ __forceinline__ void operator()(const f32x4 (&acc)[2][2][4][2], const Unit& u, int wr, int wc, int fr, int fq) const {
        const int row0 = u.pm * BM + wr * 64 + fr, col0 = u.pn * BM + wc * 32 + 8 * fq;
#pragma unroll
        for (int ai = 0; ai < 2; ++ai)
#pragma unroll
            for (int m = 0; m < 4; ++m) { const size_t off = (size_t)(row0 + ai * HALF + m * 16) * 1024 + col0;
#pragma unroll
                for (int bj = 0; bj < 2; ++bj) { const u32x4 gw = *(const u32x4*)(G + off + bj * HALF);
                    *(f32x4*)(T + off + bj * HALF) = acc[ai][bj][m][0] * bf2_to_f4(gw.x, gw.y);
                    *(f32x4*)(T + off + bj * HALF + 4) = acc[ai][bj][m][1] * bf2_to_f4(gw.z, gw.w); } }
    }
};
struct EpiMergeB {
    static constexpr bool PERM = true, AFTER_DRAIN = false;
    const bf16_t* G; const float* T; bf16_t* MIX;
    __device__ __forceinline__ void operator()(const f32x4 (&acc)[2][2][4][2], const Unit& u, int wr, int wc, int fr, int fq) const {
        const int row0 = u.pm * BM + wr * 64 + fr, col0 = u.pn * BM + wc * 32 + 8 * fq;
#pragma unroll
        for (int ai = 0; ai < 2; ++ai)
#pragma unroll
            for (int m = 0; m < 4; ++m) { const size_t off = (size_t)(row0 + ai * HALF + m * 16) * 1024 + col0;
#pragma unroll
                for (int bj = 0; bj < 2; ++bj) { const u32x4 gw = *(const u32x4*)(G + off + bj * HALF);
                    const f32x4 t0 = *(const f32x4*)(T + off + bj * HALF), t1 = *(const f32x4*)(T + off + bj * HALF + 4);
                    const f32x4 v0 = t0 + acc[ai][bj][m][0] * bf2_to_f4(gw.x, gw.y), v1 = t1 + acc[ai][bj][m][1] * bf2_to_f4(gw.z, gw.w);
                    u32x4 w; w.x = cvt_pk_bf16(v0[0], v0[1]); w.y = cvt_pk_bf16(v0[2], v0[3]); w.z = cvt_pk_bf16(v1[0], v1[1]); w.w = cvt_pk_bf16(v1[2], v1[3]);
                    *(u32x4*)(MIX + off + bj * HALF) = w; } }
    }
};
struct EpiOutProj {
    static constexpr bool PERM = false, AFTER_DRAIN = false;
    const float* X; float* OUT; bf16_t* XN; float* SS;
    __device__ __forceinline__ void operator()(const f32x4 (&acc)[2][2][4][2], const Unit& u, int wr, int wc, int fr, int fq) const {
        const int row0 = u.pm * BM + wr * 64 + fr, col0 = u.pn * BM + wc * 32 + 4 * fq;
#pragma unroll
        for (int ai = 0; ai < 2; ++ai)
#pragma unroll
            for (int m = 0; m < 4; ++m) { const int row = row0 + ai * HALF + m * 16; const size_t off = (size_t)row * 1024 + col0; float ss = 0.f;
#pragma unroll
                for (int bj = 0; bj < 2; ++bj)
#pragma unroll
                    for (int n = 0; n < 2; ++n) { const f32x4 v = *(const f32x4*)(X + off + bj * HALF + n * 16) + acc[ai][bj][m][n];
                        *(f32x4*)(OUT + off + bj * HALF + n * 16) = v; ss += (v[0] * v[0] + v[1] * v[1]) + (v[2] * v[2] + v[3] * v[3]);
                        u32x2 w; w.x = cvt_pk_bf16(v[0], v[1]); w.y = cvt_pk_bf16(v[2], v[3]); *(u32x2*)(XN + off + bj * HALF + n * 16) = w; }
                ss += __shfl_xor(ss, 16); ss += __shfl_xor(ss, 32);
                if (fq == 0) SS[(size_t)row * 16 + u.pn * 4 + wc] = ss; }
    }
};
struct EpiUp {
    static constexpr bool PERM = true, AFTER_DRAIN = false;
    const float* SS; bf16_t* H;
    __device__ __forceinline__ void operator()(const f32x4 (&acc)[2][2][4][2], const Unit& u, int wr, int wc, int fr, int fq) const {
        const int row0 = u.pm * BM + wr * 64 + fr, col0 = u.pn * BM + wc * 32 + 8 * fq;
#pragma unroll
        for (int ai = 0; ai < 2; ++ai)
#pragma unroll
            for (int m = 0; m < 4; ++m) { const int row = row0 + ai * HALF + m * 16;
                const f32x4 a = *(const f32x4*)(SS + (size_t)row * 16), b = *(const f32x4*)(SS + (size_t)row * 16 + 4), c = *(const f32x4*)(SS + (size_t)row * 16 + 8), d = *(const f32x4*)(SS + (size_t)row * 16 + 12);
                const f32x4 s4 = (a + b) + (c + d); const float r = rsqrtf(((s4[0] + s4[1]) + (s4[2] + s4[3])) * (1.0f / 1024.0f) + 1e-6f);
                bf16_t* rowp = H + (size_t)row * 4096 + col0;
#pragma unroll
                for (int bj = 0; bj < 2; ++bj) { f32x4 v0 = acc[ai][bj][m][0] * r, v1 = acc[ai][bj][m][1] * r;
#pragma unroll
                    for (int i = 0; i < 4; ++i) { v0[i] = fmaxf(v0[i], 0.f); v0[i] *= v0[i]; v1[i] = fmaxf(v1[i], 0.f); v1[i] *= v1[i]; }
                    u32x4 w; w.x = cvt_pk_bf16(v0[0], v0[1]); w.y = cvt_pk_bf16(v0[2], v0[3]); w.z = cvt_pk_bf16(v1[0], v1[1]); w.w = cvt_pk_bf16(v1[2], v1[3]);
                    *(u32x4*)(rowp + bj * HALF) = w; } }
    }
};
struct EpiDown {
    static constexpr bool PERM = false, AFTER_DRAIN = false;
    float* OUT;
    __device__ __forceinline__ void operator()(const f32x4 (&acc)[2][2][4][2], const Unit& u, int wr, int wc, int fr, int fq) const {
        const int row0 = u.pm * BM + wr * 64 + fr, col0 = u.pn * BM + wc * 32 + 4 * fq;
#pragma unroll
        for (int ai = 0; ai < 2; ++ai)
#pragma unroll
            for (int m = 0; m < 4; ++m) { float* rowp = OUT + (size_t)(row0 + ai * HALF + m * 16) * 1024 + col0;
#pragma unroll
                for (int bj = 0; bj < 2; ++bj)
#pragma unroll
                    for (int n = 0; n < 2; ++n) { f32x4* p = (f32x4*)(rowp + bj * HALF + n * 16); *p = *p + acc[ai][bj][m][n]; } }
    }
};
template <class Epi, class Sched, bool ALIGN_EPI = false, bool SP2 = false>
__device__ __forceinline__ void gemm_phase(PG8_LAS unsigned char* lds, const Gemm g, const Sched& S, const Epi& E, const int wave_in  ) {
    int tid_; asm volatile("v_mbcnt_lo_u32_b32 %0, -1, 0\n\tv_mbcnt_hi_u32_b32 %0, -1, %0" : "=v"(tid_)); tid_ += wave_in * 64;
    const int tid = tid_, wid = wave_in, lane = tid & 63, wr = wid >> 2, wc = wid & 3, fr = lane & 15, fq = lane >> 4;
    const int K = g.K, nt = K / BK;
    unsigned voffA[2], voffB[2];
#pragma unroll
    for (int i = 0; i < 2; ++i) { int R, C; stage_rc(tid * 16 + i * 8192, R, C); const int Rb = Epi::PERM ? ((R & ~31) + perm32(R & 31)) : R;
        voffA[i] = (unsigned)(R * K + C) * 2u; voffB[i] = (unsigned)(Rb * K + C) * 2u; }
    const size_t kstep = (size_t)(BK * 2);
    const size_t hstep = (size_t)HALF * K * 2;
    const size_t tstep = 2 * hstep;
    const unsigned ldsw = (unsigned)wid * 1024u;
    const int aoff = lds_byte(wr * 64 + fr, fq * 8), boff = lds_byte(wc * 32 + fr, fq * 8);
#define PG8_SA(b, h) (((b) * 2 + (h)) * HTB)
#define PG8_SB(b, h) ((4 + (b) * 2 + (h)) * HTB)
#define PG8_STAGE(bufoff, gbase, voff) do { _Pragma("unroll") for (int _i = 0; _i < 2; ++_i) \
        __builtin_amdgcn_global_load_lds((const unsigned*)((const char*)(gbase) + (voff)[_i]), (PG8_LAS unsigned*)(lds + (bufoff) + ldsw + _i * 8192), 16, 0, 0); } while (0)
#define PG8_LDA(dst, b, h) do { _Pragma("unroll") for (int m = 0; m < 4; ++m) _Pragma("unroll") for (int k = 0; k < 2; ++k) dst[m][k] = *(const PG8_LAS bf16x8*)(lds + PG8_SA(b, h) + aoff + m * 2048 + k * 1024); } while (0)
#define PG8_LDB(dst, b, h) do { _Pragma("unroll") for (int n = 0; n < 2; ++n) _Pragma("unroll") for (int k = 0; k < 2; ++k) dst[n][k] = *(const PG8_LAS bf16x8*)(lds + PG8_SB(b, h) + boff + n * 2048 + k * 1024); } while (0)
#define PG8_MMA(ai, bj, At, Bt) do { __builtin_amdgcn_s_setprio(1); _Pragma("unroll") for (int m = 0; m < 4; ++m) _Pragma("unroll") for (int n = 0; n < 2; ++n) _Pragma("unroll") for (int k = 0; k < 2; ++k) \
        acc[ai][bj][m][n] = __builtin_amdgcn_mfma_f32_16x16x32_bf16(Bt[n][k], At[m][k], acc[ai][bj][m][n], 0, 0, 0); __builtin_amdgcn_s_setprio(0); } while (0)
#define PG8_WAIT_V(n) asm volatile("s_waitcnt vmcnt(" #n ")" ::: "memory")
#define PG8_WAIT_L(n) asm volatile("s_waitcnt lgkmcnt(" #n ")" ::: "memory")
#define PG8_BAR __builtin_amdgcn_s_barrier()
#define PG8_SCHED __builtin_amdgcn_sched_barrier(0)
    Unit cur, nxt; int ui = 0;
    if (!S.next(0, cur)) return;
    f32x4 acc[2][2][4][2];
#pragma unroll
    for (int a = 0; a < 2; ++a)
#pragma unroll
        for (int b = 0; b < 2; ++b)
#pragma unroll
            for (int m = 0; m < 4; ++m)
#pragma unroll
                for (int n = 0; n < 2; ++n) acc[a][b][m][n] = (f32x4){0.f, 0.f, 0.f, 0.f};
    bf16x8 At[4][2], B0[2][2], B1[2][2];
    const char* cA = (const char*)g.A + (size_t)cur.pm * tstep; const char* cB = (const char*)g.Bt + (size_t)cur.pn * tstep;
    S.a_ready(cur);
    if constexpr (SP2) {
        PG8_STAGE(PG8_SB(0, 0), cB, voffB); PG8_STAGE(PG8_SB(0, 1), cB + hstep, voffB); PG8_STAGE(PG8_SA(0, 0), cA, voffA); PG8_STAGE(PG8_SA(0, 1), cA + hstep, voffA);
        if (wr == 1) PG8_BAR;
        PG8_WAIT_V(2); PG8_BAR;
        PG8_STAGE(PG8_SB(1, 0), cB + kstep, voffB); PG8_STAGE(PG8_SA(1, 0), cA + kstep, voffA); PG8_STAGE(PG8_SB(1, 1), cB + hstep + kstep, voffB);
        PG8_WAIT_V(6); PG8_BAR;
    } else {
        PG8_STAGE(PG8_SB(0, 0), cB, voffB); PG8_STAGE(PG8_SA(0, 0), cA, voffA); PG8_STAGE(PG8_SB(0, 1), cB + hstep, voffB); PG8_STAGE(PG8_SA(0, 1), cA + hstep, voffA);
        if (wr == 1) PG8_BAR;
        PG8_WAIT_V(4); PG8_BAR;
        PG8_STAGE(PG8_SB(1, 0), cB + kstep, voffB); PG8_STAGE(PG8_SA(1, 0), cA + kstep, voffA); PG8_STAGE(PG8_SB(1, 1), cB + hstep + kstep, voffB);
        PG8_WAIT_V(6); PG8_BAR;
    }
    for (;;) {
        const bool has_next = S.next(ui + 1, nxt);
        const char* nA = has_next ? (const char*)g.A + (size_t)nxt.pm * tstep : cA; const char* nB = has_next ? (const char*)g.Bt + (size_t)nxt.pn * tstep : cB;
        for (int t = 0; t < nt; t += 2) {
            const bool last = (t == nt - 2);
            const char* a1 = cA + (size_t)(t + 1) * kstep;
            const char* a2 = last ? nA : cA + (size_t)(t + 2) * kstep; const char* b2 = last ? nB : cB + (size_t)(t + 2) * kstep;
            const char* a3 = a2 + kstep; const char* b3 = b2 + kstep;
            if (last && has_next) S.a_ready(nxt);
            if constexpr (SP2) {
            PG8_LDB(B0, 0, 0); PG8_LDB(B1, 0, 1); PG8_SCHED; PG8_LDA(At, 0, 0); PG8_STAGE(PG8_SA(1, 1), a1 + hstep, voffA);
            PG8_WAIT_V(8); PG8_WAIT_L(0); PG8_BAR; PG8_MMA(0, 0, At, B0); PG8_MMA(0, 1, At, B1); PG8_BAR; PG8_SCHED;
            PG8_LDA(At, 0, 1); PG8_STAGE(PG8_SB(0, 0), b2, voffB); PG8_STAGE(PG8_SB(0, 1), b2 + hstep, voffB); PG8_STAGE(PG8_SA(0, 0), a2, voffA);
            PG8_WAIT_V(8); PG8_WAIT_L(0); PG8_BAR; PG8_MMA(1, 0, At, B0); PG8_MMA(1, 1, At, B1); PG8_BAR; PG8_SCHED;
            PG8_LDB(B0, 1, 0); PG8_LDB(B1, 1, 1); PG8_SCHED; PG8_LDA(At, 1, 0); PG8_STAGE(PG8_SA(0, 1), a2 + hstep, voffA);
            PG8_WAIT_V(8); PG8_WAIT_L(0); PG8_BAR; PG8_MMA(0, 0, At, B0); PG8_MMA(0, 1, At, B1); PG8_BAR; PG8_SCHED;
            PG8_LDA(At, 1, 1); PG8_STAGE(PG8_SB(1, 0), b3, voffB); PG8_STAGE(PG8_SB(1, 1), b3 + hstep, voffB); PG8_STAGE(PG8_SA(1, 0), a3, voffA);
            PG8_WAIT_V(8); PG8_WAIT_L(0); PG8_BAR; PG8_MMA(1, 0, At, B0); PG8_MMA(1, 1, At, B1); PG8_BAR; PG8_SCHED;
            } else {
            PG8_LDB(B0, 0, 0); PG8_SCHED; PG8_LDA(At, 0, 0); PG8_STAGE(PG8_SA(1, 1), a1 + hstep, voffA);
            PG8_WAIT_L(8); PG8_BAR; PG8_WAIT_L(0); PG8_MMA(0, 0, At, B0); PG8_BAR; PG8_SCHED;
            PG8_LDB(B1, 0, 1); PG8_STAGE(PG8_SB(0, 0), b2, voffB);
            PG8_BAR; PG8_WAIT_L(0); PG8_MMA(0, 1, At, B1); PG8_BAR;
            PG8_LDA(At, 0, 1); PG8_STAGE(PG8_SA(0, 0), a2, voffA);
            PG8_BAR; PG8_WAIT_L(0); PG8_MMA(1, 0, At, B0); PG8_BAR; PG8_SCHED;
            PG8_STAGE(PG8_SB(0, 1), b2 + hstep, voffB);
            PG8_WAIT_V(6); PG8_BAR; PG8_MMA(1, 1, At, B1); PG8_BAR;
            PG8_LDB(B0, 1, 0); PG8_SCHED; PG8_LDA(At, 1, 0); PG8_STAGE(PG8_SA(0, 1), a2 + hstep, voffA);
            PG8_WAIT_L(8); PG8_BAR; PG8_WAIT_L(0); PG8_MMA(0, 0, At, B0); PG8_BAR; PG8_SCHED;
            PG8_LDB(B1, 1, 1); PG8_STAGE(PG8_SB(1, 0), b3, voffB);
            PG8_BAR; PG8_WAIT_L(0); PG8_MMA(0, 1, At, B1); PG8_BAR;
            PG8_LDA(At, 1, 1); PG8_STAGE(PG8_SA(1, 0), a3, voffA);
            PG8_BAR; PG8_WAIT_L(0); PG8_MMA(1, 0, At, B0); PG8_BAR; PG8_SCHED;
            PG8_STAGE(PG8_SB(1, 1), b3 + hstep, voffB);
            PG8_WAIT_V(6); PG8_BAR; PG8_MMA(1, 1, At, B1); PG8_BAR;
            }
        }
        if constexpr (ALIGN_EPI) { if (wr == 0) PG8_BAR; }
        if constexpr (!Epi::AFTER_DRAIN) { E(acc, cur, wr, wc, fr, fq); S.done(cur); }
        if (!has_next) break;
#pragma unroll
        for (int a = 0; a < 2; ++a)
#pragma unroll
            for (int b = 0; b < 2; ++b)
#pragma unroll
                for (int m = 0; m < 4; ++m)
#pragma unroll
                    for (int n = 0; n < 2; ++n) acc[a][b][m][n] = (f32x4){0.f, 0.f, 0.f, 0.f};
        cur = nxt; cA = nA; cB = nB; ++ui;
        if constexpr (ALIGN_EPI) { if (wr == 1) PG8_BAR; }
    }
    PG8_WAIT_V(0);
    if constexpr (!ALIGN_EPI) { if (wr == 0) PG8_BAR; }
    PG8_BAR;
    if constexpr (Epi::AFTER_DRAIN) { E.fused(acc, cur, wr, wc, fr, fq, lds, wid, lane); S.done(cur); }
#undef PG8_SA
#undef PG8_SB
#undef PG8_STAGE
#undef PG8_LDA
#undef PG8_LDB
#undef PG8_MMA
#undef PG8_WAIT_V
#undef PG8_WAIT_L
#undef PG8_BAR
#undef PG8_SCHED
}
}
#define GAS __attribute__((address_space(1)))
#define LAS __attribute__((address_space(3)))
typedef unsigned short bf16;
typedef unsigned v4u __attribute__((ext_vector_type(4)));
typedef unsigned v2u __attribute__((ext_vector_type(2)));
typedef float f32x4 __attribute__((ext_vector_type(4)));
typedef float f32x16 __attribute__((ext_vector_type(16)));
typedef short bf16x8 __attribute__((ext_vector_type(8)));
typedef short s16x4 __attribute__((ext_vector_type(4)));
typedef GAS unsigned gu32;
#define RLX_AGENT __ATOMIC_RELAXED, __HIP_MEMORY_SCOPE_AGENT
#define LDS_WAIT() asm volatile("s_waitcnt lgkmcnt(0)" ::: "memory")
#define VM_WAIT() asm volatile("s_waitcnt vmcnt(0)" ::: "memory")
__device__ __forceinline__ unsigned f2bf(float f) { unsigned u = __builtin_bit_cast(unsigned, f); return (u + 0x7fffu + ((u >> 16) & 1u)) >> 16; }
__device__ __forceinline__ unsigned pk2(float lo, float hi) { return f2bf(lo) | (f2bf(hi) << 16); }
__device__ __forceinline__ int mk_lane_() { int l; asm volatile("v_mbcnt_lo_u32_b32 %0, -1, 0\n\tv_mbcnt_hi_u32_b32 %0, -1, %0" : "=v"(l)); return l; }
#define MK_LANE() mk_lane_()
#define XB_TMO      128
#define XB_XCNT(j)  (256  + 64 * (j))
#define XB_XSUB(j)  (1280 + 64 * (j))
#define XB_XGEN(j)  (2304 + 64 * (j))
#define XB_TOP      3328
#define XB_TOPGEN   3392
#define XCD_BAR_WORDS 3456
#define XB_SPIN_CAP (1u << 18)

__device__ __forceinline__ unsigned xb_ld(unsigned* p)              { return __hip_atomic_load(p, __ATOMIC_RELAXED, __HIP_MEMORY_SCOPE_AGENT); }
__device__ __forceinline__ unsigned xb_add(unsigned* p, unsigned v) { return __hip_atomic_fetch_add(p, v, __ATOMIC_RELAXED, __HIP_MEMORY_SCOPE_AGENT); }
__device__ __forceinline__ unsigned xb_xcc_id() { return (unsigned)__builtin_amdgcn_s_getreg((3 << 11) | 20) & 0xFu; }
#define XB_SPIN(cond, bar) do { unsigned _sp = 0; while (cond) { __builtin_amdgcn_s_sleep(1); \
    if ((++_sp & 255u) == 0u) { if (xb_ld(&(bar)[XB_TMO])) break; if (_sp > XB_SPIN_CAP) { atomicAdd(&(bar)[XB_TMO], 1u); break; } } } } while (0)

struct XcdBarrier {
    unsigned* bar; unsigned x; int wave;
    volatile LAS unsigned* st;
};

__device__ __forceinline__ XcdBarrier xcd_barrier_post(unsigned* bar, volatile LAS unsigned* st, int wave) {
    XcdBarrier b; b.bar = bar; b.x = xb_xcc_id(); b.st = st; b.wave = wave;
    if (wave == 0 && MK_LANE() == 0) (void)xb_add(&bar[XB_XCNT(b.x)], 1u);
    return b;
}
__device__ __forceinline__ void xcd_barrier_complete(unsigned* bar, unsigned x, unsigned& nloc, unsigned& nx) {
    const unsigned G = gridDim.x * gridDim.y * gridDim.z;
    unsigned sum, cnt, mine, sp = 0u;
    for (;;) {
        sum = 0u; cnt = 0u; mine = 0u;
#pragma unroll
        for (unsigned j = 0; j < 16; ++j) { const unsigned c = xb_ld(&bar[XB_XCNT(j)]); sum += c; cnt += (c > 0u) ? 1u : 0u; mine = (j == x) ? c : mine; }
        if (sum == G) break;
        __builtin_amdgcn_s_sleep(1);
        if ((++sp & 255u) == 0u) { if (xb_ld(&bar[XB_TMO])) break; if (sp > XB_SPIN_CAP) { atomicAdd(&bar[XB_TMO], 1u); break; } }
    }
    nloc = mine > 0u ? mine : 1u; nx = cnt > 0u ? cnt : 1u;
}

__device__ __forceinline__ void xcd_barrier(const XcdBarrier& b) {
    asm volatile("s_waitcnt vmcnt(0)" ::: "memory");
    __syncthreads();
    if (b.wave == 0 && MK_LANE() == 0) {
        unsigned* bar = b.bar;
        __builtin_amdgcn_s_waitcnt(0);
        unsigned nloc = b.st[0], nx = b.st[1];
        if (nloc == 0u) { xcd_barrier_complete(bar, b.x, nloc, nx); b.st[0] = nloc; b.st[1] = nx; }
        const unsigned old = xb_add(&bar[XB_XSUB(b.x)], 1u);
        const unsigned gen = old / nloc;
        if (old + 1u == (gen + 1u) * nloc) {
            __builtin_amdgcn_fence(__ATOMIC_RELEASE, "agent");
            asm volatile("s_waitcnt vmcnt(0)" ::: "memory");
            const unsigned og = xb_add(&bar[XB_TOP], 1u);
            const unsigned tg = og / nx;
            if (og + 1u == (tg + 1u) * nx) xb_add(&bar[XB_TOPGEN], 1u);
            else XB_SPIN(xb_ld(&bar[XB_TOPGEN]) == tg, bar);
            __builtin_amdgcn_fence(__ATOMIC_ACQUIRE, "agent");
            xb_add(&bar[XB_XGEN(b.x)], 1u);
            asm volatile("s_waitcnt vmcnt(0)" ::: "memory");
        } else {
            XB_SPIN(xb_ld(&bar[XB_XGEN(b.x)]) == gen, bar);
            __builtin_amdgcn_fence(__ATOMIC_ACQUIRE, "agent");
            asm volatile("s_waitcnt vmcnt(0)" ::: "memory");
        }
    }
    __syncthreads();
}
constexpr int NWAVES = 8;
constexpr int BATCH = 8, SEQ = 4096, DM = 1024, FF = 4096, INW = 5120;
constexpr int M = BATCH * SEQ;
constexpr size_t MiB = 1u << 20;
constexpr size_t WS_CTL = 0, CTL_ZERO_BYTES = 64 * 1024;
constexpr size_t WS_WIN = 2 * MiB, WS_WA = 12 * MiB, WS_WB = 13 * MiB, WS_WO = 14 * MiB, WS_W1 = 16 * MiB, WS_W2 = 24 * MiB;
constexpr size_t WS_CS = 32 * MiB, WS_SS = 34 * MiB, WS_LSE = 36 * MiB;
constexpr size_t WS_XN = 40 * MiB;
constexpr size_t WS_QA = 104 * MiB, WS_KA = 152 * MiB, WS_VA = 200 * MiB, WS_QB = 248 * MiB, WS_KB = 280 * MiB, WS_VB = 288 * MiB;
constexpr size_t WS_GA = 296 * MiB, WS_GB = 360 * MiB, WS_OA = 424 * MiB, WS_MIX = 440 * MiB, WS_END = 504 * MiB;
constexpr size_t WS_H = 104 * MiB;
static_assert(WS_H + (size_t)M * FF * 2 <= WS_GB, "hidden overlay");
constexpr int CW_BAR = 1024;
constexpr int RING_OFF = 0, RING_BYTES = 131072, LDSCTL_OFF = RING_BYTES, MISC_OFF = LDSCTL_OFF + 320, LDS_BYTES = 147456;

struct Args { const float* in[15]; float* out; unsigned char* ws; };

__device__ __forceinline__ float wave_sum(float v) {
#pragma unroll
    for (int o = 1; o < 64; o <<= 1) v += __shfl_xor(v, o);
    return v;
}
__device__ __forceinline__ void p0_transpose_item(const float* W, int K, int N, bf16* WT, bool permute, const float* kscale, LAS float* scr, int item, int lane) {
    const int nblk = N / 32, kb = item / nblk, nb = item % nblk, k0 = 64 * kb, n0 = 32 * nb;
#pragma unroll 8
    for (int i = 0; i < 32; ++i) { const int kk = 2 * i + (lane >> 5); float v = W[(size_t)(k0 + kk) * N + n0 + (lane & 31)]; if (kscale) v *= kscale[k0 + kk]; scr[kk * 33 + (lane & 31)] = v; }
    LDS_WAIT(); asm volatile("" ::: "memory");
    const int c = lane & 7;
    const int p0 = permute ? ((n0 & ~255) + 128 * ((n0 >> 5) & 1) + 32 * ((n0 >> 6) & 3)) : n0;
#pragma unroll
    for (int j = 0; j < 4; ++j) { const int n = (lane >> 3) + 8 * j; const LAS float* s = scr + (8 * c) * 33 + n;
        v4u o; o.x = pk2(s[0 * 33], s[1 * 33]); o.y = pk2(s[2 * 33], s[3 * 33]); o.z = pk2(s[4 * 33], s[5 * 33]); o.w = pk2(s[6 * 33], s[7 * 33]);
        *(GAS v4u*)(WT + (size_t)(p0 + n) * K + k0 + 8 * c) = o; }
    LDS_WAIT(); asm volatile("" ::: "memory");
}
__device__ __forceinline__ void rms_row_to_bf16(const float* xrow, const float* g, bf16* orow, int lane) {
    const GAS f32x4* xr = (const GAS f32x4*)xrow + lane; const GAS f32x4* gr = (const GAS f32x4*)g + lane;
    f32x4 v[4]; float s = 0.f;
#pragma unroll
    for (int j = 0; j < 4; ++j) { v[j] = xr[64 * j]; s += (v[j].x * v[j].x + v[j].y * v[j].y) + (v[j].z * v[j].z + v[j].w * v[j].w); }
    const float r = rsqrtf(wave_sum(s) * (1.f / DM) + 1e-6f);
    GAS unsigned long long* o8 = (GAS unsigned long long*)orow + lane;
#pragma unroll
    for (int j = 0; j < 4; ++j) { const f32x4 gg = gr[64 * j]; o8[64 * j] = (unsigned long long)pk2(v[j].x * r * gg.x, v[j].y * r * gg.y) | ((unsigned long long)pk2(v[j].z * r * gg.z, v[j].w * r * gg.w) << 32); }
}

namespace att {
constexpr int K_OFF = 0, V_OFF = 384 * 128, ATT_LDS = 2 * 384 * 128;
constexpr int N_DIL_UNITS = BATCH * 12 * 16, N_SWA_UNITS = BATCH * 8 * 16, N_UNITS = N_DIL_UNITS + N_SWA_UNITS;
__device__ __forceinline__ int crow(int r, int hi) { return (r & 3) + 8 * (r >> 2) + 4 * hi; }
struct Ptrs { bf16 *QA, *KA, *VA, *QB, *KB, *VB; float* LSE; const float* sinks; };

__device__ __forceinline__ void attn_unit(int u, const Ptrs& P, LAS unsigned char* lds, int wid) {
    int lane = MK_LANE(); asm volatile("" : "+v"(lane)); const int tid = wid * 64 + lane;
    const bf16 *Qp, *Kp, *Vp; bf16* Op; float* lsep = nullptr; long qpitch, kpitch, lpitch = 0; int i0, wlo; float sink2 = 0.f; bool has_sink = false;
    if (u < N_DIL_UNITS) {
        const int b = u / 192, rem = u % 192, head = rem >> 4, blk = rem & 15, g = head >> 2, dil = 1 << (2 * g), bps = 16 >> (2 * g), n = blk / bps, qb = blk % bps;
        const long row0 = (long)b * SEQ + n;
        Qp = P.QA + row0 * 768 + head * 64; Kp = P.KA + row0 * 768 + head * 64; Vp = P.VA + row0 * 768 + head * 64; Op = P.QA + row0 * 768 + head * 64;
        qpitch = 768L * dil; kpitch = 768L * dil; lsep = P.LSE + row0 * 12 + head; lpitch = 12L * dil; i0 = qb * 256; wlo = 0;
    } else {
        const int v = u - N_DIL_UNITS, b = v >> 7, rem = v & 127, hq = rem >> 4, qb = rem & 15;
        const long row0 = (long)b * SEQ;
        Qp = P.QB + row0 * 512 + hq * 64; Kp = P.KB + row0 * 128 + (hq >> 2) * 64; Vp = P.VB + row0 * 128 + (hq >> 2) * 64; Op = P.QB + row0 * 512 + hq * 64;
        qpitch = 512; kpitch = 128; i0 = qb * 256; wlo = 1; has_sink = true; sink2 = P.sinks[hq] * 1.4426950408889634f;
    }
    {
        v4u kreg[6], vreg[6];
#pragma unroll
        for (int j = 0; j < 6; ++j) { const int c = tid + 512 * j, r = c >> 3, ch = c & 7, i = i0 - 128 + r;
            if (i >= 0) { kreg[j] = *(const GAS v4u*)(Kp + (long)i * kpitch + ch * 8); vreg[j] = *(const GAS v4u*)(Vp + (long)i * kpitch + ch * 8); }
            else { kreg[j] = (v4u){0u, 0u, 0u, 0u}; vreg[j] = (v4u){0u, 0u, 0u, 0u}; } }
#pragma unroll
        for (int j = 0; j < 6; ++j) { const int c = tid + 512 * j, r = c >> 3, ch = c & 7;
            *(LAS v4u*)(lds + K_OFF + r * 128 + ((ch ^ ((r >> 1) & 7)) << 4)) = kreg[j];
            *(LAS v4u*)(lds + V_OFF + r * 128 + (ch << 4)) = vreg[j]; }
    }
    const int x = lane & 31, hi = lane >> 5;
    const long qrow = i0 + 32 * wid + x;
    bf16x8 qf[4];
#pragma unroll
    for (int ks = 0; ks < 4; ++ks) qf[ks] = *(const GAS bf16x8*)(Qp + qrow * qpitch + 16 * ks + 8 * hi);
    __syncthreads();
    f32x16 S[5];
#pragma unroll
    for (int c = 0; c < 5; ++c) {
        const int krow = 32 * wid + 32 * c + x;
        f32x16 a = {};
#pragma unroll
        for (int ks = 0; ks < 4; ++ks) { const bf16x8 kf = *(const LAS bf16x8*)(lds + K_OFF + krow * 128 + (((2 * ks + hi) ^ ((krow >> 1) & 7)) << 4));
            a = __builtin_amdgcn_mfma_f32_32x32x16_bf16(kf, qf[ks], a, 0, 0, 0); }
        S[c] = a;
    }
    const float NEG = -INFINITY;
#pragma unroll
    for (int r = 0; r < 16; ++r) { const int y = crow(r, hi); if (y < x + wlo) S[0][r] = NEG; if (y > x) S[4][r] = NEG; }
    if (i0 == 0 && wid < 4) {
#pragma unroll
        for (int c = 0; c < 4; ++c) if (c < 4 - wid) {
#pragma unroll
            for (int r = 0; r < 16; ++r) S[c][r] = NEG; }
    }
    float m = NEG;
#pragma unroll
    for (int c = 0; c < 5; ++c)
#pragma unroll
        for (int r = 0; r < 16; ++r) m = fmaxf(m, S[c][r]);
    m = fmaxf(m, __shfl_xor(m, 32));
    if (has_sink) m = fmaxf(m, sink2);
    float l = 0.f;
#pragma unroll
    for (int c = 0; c < 5; ++c)
#pragma unroll
        for (int r = 0; r < 16; ++r) { const float p = __builtin_amdgcn_exp2f(S[c][r] - m); S[c][r] = p; l += p; }
    l += __shfl_xor(l, 32);
    if (has_sink) l += __builtin_amdgcn_exp2f(sink2 - m);
    f32x16 o0 = {}, o1 = {};
    const LAS unsigned char* vb = lds + V_OFF + (32 * wid + 4 * hi + ((lane & 15) >> 2)) * 128 + (16 * ((lane >> 4) & 1) + 4 * (lane & 3)) * 2;
#pragma unroll
    for (int c = 0; c < 5; ++c)
#pragma unroll
        for (int s = 0; s < 2; ++s) {
            v4u pw; pw.x = pg8::cvt_pk_bf16(S[c][8 * s + 0], S[c][8 * s + 1]); pw.y = pg8::cvt_pk_bf16(S[c][8 * s + 2], S[c][8 * s + 3]);
            pw.z = pg8::cvt_pk_bf16(S[c][8 * s + 4], S[c][8 * s + 5]); pw.w = pg8::cvt_pk_bf16(S[c][8 * s + 6], S[c][8 * s + 7]);
            const bf16x8 pf = __builtin_bit_cast(bf16x8, pw);
            const LAS unsigned char* vp = vb + (32 * c + 16 * s) * 128;
            const s16x4 a0 = __builtin_bit_cast(s16x4, __builtin_amdgcn_ds_read_tr16_b64_v4i16((LAS s16x4*)(vp)));
            const s16x4 a1 = __builtin_bit_cast(s16x4, __builtin_amdgcn_ds_read_tr16_b64_v4i16((LAS s16x4*)(vp + 8 * 128)));
            const s16x4 b0 = __builtin_bit_cast(s16x4, __builtin_amdgcn_ds_read_tr16_b64_v4i16((LAS s16x4*)(vp + 64)));
            const s16x4 b1 = __builtin_bit_cast(s16x4, __builtin_amdgcn_ds_read_tr16_b64_v4i16((LAS s16x4*)(vp + 8 * 128 + 64)));
            const bf16x8 vf0 = (bf16x8){a0[0], a0[1], a0[2], a0[3], a1[0], a1[1], a1[2], a1[3]};
            const bf16x8 vf1 = (bf16x8){b0[0], b0[1], b0[2], b0[3], b1[0], b1[1], b1[2], b1[3]};
            o0 = __builtin_amdgcn_mfma_f32_32x32x16_bf16(vf0, pf, o0, 0, 0, 0);
            o1 = __builtin_amdgcn_mfma_f32_32x32x16_bf16(vf1, pf, o1, 0, 0, 0);
        }
    const float inv = 1.0f / l;
    bf16* orow = Op + qrow * qpitch;
#pragma unroll
    for (int rg = 0; rg < 4; ++rg) {
        v2u w0, w1;
        w0.x = pg8::cvt_pk_bf16(o0[4 * rg + 0] * inv, o0[4 * rg + 1] * inv); w0.y = pg8::cvt_pk_bf16(o0[4 * rg + 2] * inv, o0[4 * rg + 3] * inv);
        w1.x = pg8::cvt_pk_bf16(o1[4 * rg + 0] * inv, o1[4 * rg + 1] * inv); w1.y = pg8::cvt_pk_bf16(o1[4 * rg + 2] * inv, o1[4 * rg + 3] * inv);
        *(GAS v2u*)(orow + 8 * rg + 4 * hi) = w0; *(GAS v2u*)(orow + 32 + 8 * rg + 4 * hi) = w1;
    }
    if (lsep && hi == 0) lsep[qrow * lpitch] = m + __builtin_amdgcn_logf(l);
    __syncthreads();
}
}

__global__ void __launch_bounds__(NWAVES * 64, 2) fwd_megakernel(Args args) {
    extern __shared__ __attribute__((aligned(16))) unsigned char lds_raw[];
    LAS unsigned char* lds = (LAS unsigned char*)lds_raw;
    volatile LAS unsigned* MISC = (volatile LAS unsigned*)(lds + MISC_OFF);
    const int wave = __builtin_amdgcn_readfirstlane((int)(threadIdx.x >> 6));
#define TID() (wave * 64 + MK_LANE())
    const int G = gridDim.x, bx = blockIdx.x, vcu = (G % 8 == 0) ? (bx % 8) * (G / 8) + bx / 8 : bx;
    unsigned char* ws = args.ws;
    gu32* ctl = (gu32*)(ws + WS_CTL);
    const float* x = args.in[0]; const int* positions = (const int*)args.in[1]; const float* ln1_g = args.in[2]; const float* w_in = args.in[3];
    const float *qna = args.in[4], *kna = args.in[5], *qnb = args.in[6], *knb = args.in[7], *sinks = args.in[8];
    const float *w_a = args.in[9], *w_b = args.in[10], *w_o = args.in[11], *ln2_g = args.in[12], *w_up = args.in[13], *w_down = args.in[14];
    float* out = args.out;
    bf16 *Win_t = (bf16*)(ws + WS_WIN), *Wa_t = (bf16*)(ws + WS_WA), *Wb_t = (bf16*)(ws + WS_WB), *Wo_t = (bf16*)(ws + WS_WO), *W1_t = (bf16*)(ws + WS_W1), *W2_t = (bf16*)(ws + WS_W2);
    float *CS = (float*)(ws + WS_CS), *SS = (float*)(ws + WS_SS), *LSE = (float*)(ws + WS_LSE);
    bf16 *XN = (bf16*)(ws + WS_XN), *QA = (bf16*)(ws + WS_QA), *KA = (bf16*)(ws + WS_KA), *VA = (bf16*)(ws + WS_VA), *QB = (bf16*)(ws + WS_QB), *KB = (bf16*)(ws + WS_KB), *VB = (bf16*)(ws + WS_VB);
    bf16 *GA = (bf16*)(ws + WS_GA), *GB = (bf16*)(ws + WS_GB), *OA = (bf16*)(ws + WS_OA), *MIX = (bf16*)(ws + WS_MIX), *HB = (bf16*)(ws + WS_H);

    for (int u = TID(); u < (LDS_BYTES - LDSCTL_OFF) / 4; u += NWAVES * 64) ((LAS unsigned*)(lds + LDSCTL_OFF))[u] = 0u;
    __syncthreads();
    XcdBarrier bar = xcd_barrier_post((unsigned*)(ctl + CW_BAR), MISC + 8, wave);
    const int gw = vcu * NWAVES + wave, NGW = G * NWAVES;

    {
        LAS float* scr = (LAS float*)(lds + RING_OFF + wave * 16384);
        constexpr int I_IN = (DM / 64) * (INW / 32), I_A = (256 / 64) * (DM / 32), I_B = (512 / 64) * (DM / 32), I_O = (DM / 64) * (DM / 32), I_1 = (DM / 64) * (FF / 32), I_2 = (FF / 64) * (DM / 32);
        constexpr int NITEMS = I_IN + I_A + I_B + I_O + I_1 + I_2;
        for (int it = gw; it < NITEMS; it += NGW) {
            int r = it;
            if (r < I_IN) { p0_transpose_item(w_in, DM, INW, Win_t, true, nullptr, scr, r, MK_LANE()); continue; } r -= I_IN;
            if (r < I_A) { p0_transpose_item(w_a, 256, DM, Wa_t, false, nullptr, scr, r, MK_LANE()); continue; } r -= I_A;
            if (r < I_B) { p0_transpose_item(w_b, 512, DM, Wb_t, false, nullptr, scr, r, MK_LANE()); continue; } r -= I_B;
            if (r < I_O) { p0_transpose_item(w_o, DM, DM, Wo_t, false, nullptr, scr, r, MK_LANE()); continue; } r -= I_O;
            if (r < I_1) { p0_transpose_item(w_up, DM, FF, W1_t, false, ln2_g, scr, r, MK_LANE()); continue; } r -= I_1;
            p0_transpose_item(w_down, FF, DM, W2_t, false, nullptr, scr, r, MK_LANE());
        }
        for (int idx = (vcu * NWAVES * 64 + TID()); idx < M * 8; idx += G * NWAVES * 64) {
            const int row = idx >> 3, j = idx & 7;
            const float invf = powf(500000.0f, -(float)(2 * j) / 16.0f);
            const float ang = (float)positions[row] * invf;
            CS[(size_t)row * 16 + j] = cosf(ang); CS[(size_t)row * 16 + 8 + j] = sinf(ang);
        }
        for (int m = gw; m < M; m += NGW) rms_row_to_bf16(x + (size_t)m * DM, ln1_g, XN + (size_t)m * DM, MK_LANE());
    }
    xcd_barrier(bar);

    {
        pg8::Gemm g{XN, Win_t, M, INW, DM}; pg8::StaticOrder S; S.init(M, INW, G, bx);
        pg8::EpiInProj E{QA, KA, VA, QB, KB, VB, GA, GB, CS, qna, kna, qnb, knb};
        pg8::gemm_phase<pg8::EpiInProj, pg8::StaticOrder, true, true>(lds + RING_OFF, g, S, E, wave);
    }
    xcd_barrier(bar);

    {
        att::Ptrs P{QA, KA, VA, QB, KB, VB, LSE, sinks};
        for (int u = vcu; u < att::N_UNITS; u += G) att::attn_unit(u, P, lds + RING_OFF, wave);
    }
    xcd_barrier(bar);

    for (int t = gw; t < M; t += NGW) {
        const int lane = MK_LANE(); const int j = lane >> 4;
        const float l0 = LSE[(size_t)t * 12 + j], l1 = LSE[(size_t)t * 12 + 4 + j], l2 = LSE[(size_t)t * 12 + 8 + j];
        const float mx = fmaxf(l0, fmaxf(l1, l2));
        const float e0 = __builtin_amdgcn_exp2f(l0 - mx), e1 = __builtin_amdgcn_exp2f(l1 - mx), e2 = __builtin_amdgcn_exp2f(l2 - mx);
        const float inv = 1.0f / (e0 + e1 + e2);
        const bf16* o3 = QA + (size_t)t * 768 + 4 * lane;
        const v2u a = *(const GAS v2u*)(o3), b = *(const GAS v2u*)(o3 + 256), c = *(const GAS v2u*)(o3 + 512);
        const f32x4 fa = pg8::bf2_to_f4(a.x, a.y), fb = pg8::bf2_to_f4(b.x, b.y), fc = pg8::bf2_to_f4(c.x, c.y);
        const f32x4 r = (fa * e0 + fb * e1 + fc * e2) * inv;
        v2u w; w.x = pk2(r[0], r[1]); w.y = pk2(r[2], r[3]);
        *(GAS v2u*)(OA + (size_t)t * 256 + 4 * lane) = w;
    }
    xcd_barrier(bar);

    {
        pg8::StaticOrder S; S.init(M, DM, G, bx);
        { pg8::Gemm g{OA, Wa_t, M, DM, 256}; pg8::EpiMergeA E{GA, out};
          pg8::gemm_phase<pg8::EpiMergeA, pg8::StaticOrder, true, true>(lds + RING_OFF, g, S, E, wave); }
        VM_WAIT(); __syncthreads();
        { pg8::Gemm g{QB, Wb_t, M, DM, 512}; pg8::EpiMergeB E{GB, out, MIX};
          pg8::gemm_phase<pg8::EpiMergeB, pg8::StaticOrder, true, true>(lds + RING_OFF, g, S, E, wave); }
    }
    xcd_barrier(bar);

    {
        pg8::Gemm g{MIX, Wo_t, M, DM, DM}; pg8::StaticOrder S; S.init(M, DM, G, bx);
        pg8::EpiOutProj E{x, out, XN, SS};
        pg8::gemm_phase<pg8::EpiOutProj, pg8::StaticOrder, true, true>(lds + RING_OFF, g, S, E, wave);
    }
    xcd_barrier(bar);

    {
        pg8::Gemm g{XN, W1_t, M, FF, DM}; pg8::StaticOrder S; S.init(M, FF, G, bx);
        pg8::EpiUp E{SS, HB};
        pg8::gemm_phase<pg8::EpiUp, pg8::StaticOrder, true, true>(lds + RING_OFF, g, S, E, wave);
    }
    xcd_barrier(bar);

    {
        pg8::Gemm g{HB, W2_t, M, DM, FF}; pg8::StaticOrder S; S.init(M, DM, G, bx);
        pg8::EpiDown E{out};
        pg8::gemm_phase<pg8::EpiDown, pg8::StaticOrder, true, true>(lds + RING_OFF, g, S, E, wave);
    }
}

extern "C" void kernel_launch(void* const* d_in, const int* in_sizes, int n_in, void* d_out, int out_size, void* d_ws, size_t ws_size, hipStream_t stream) {
    static int grid = 0;
    if (grid == 0) {
        if (n_in != 15 || in_sizes[0] != M * DM || out_size != M * DM || ws_size < WS_END) { fprintf(stderr, "kernel_launch: unexpected shapes (n_in %d in0 %d out %d ws %zu)\n", n_in, n_in > 0 ? in_sizes[0] : -1, out_size, ws_size); grid = -1; return; }
        int dev = 0, cus = 0, per_cu = 0;
        if (hipGetDevice(&dev) != hipSuccess || hipDeviceGetAttribute(&cus, hipDeviceAttributeMultiprocessorCount, dev) != hipSuccess) { grid = -1; return; }
        if (hipFuncSetAttribute((const void*)fwd_megakernel, hipFuncAttributeMaxDynamicSharedMemorySize, LDS_BYTES) != hipSuccess) { fprintf(stderr, "kernel_launch: hipFuncSetAttribute failed\n"); grid = -1; return; }
        if (hipOccupancyMaxActiveBlocksPerMultiprocessor(&per_cu, (const void*)fwd_megakernel, NWAVES * 64, LDS_BYTES) != hipSuccess || per_cu < 1) { fprintf(stderr, "kernel_launch: occupancy query says %d blocks per CU\n", per_cu); (void)hipGetLastError(); grid = -1; return; }
        grid = cus;
    }
    if (grid < 0) return;
    (void)hipMemsetAsync((char*)d_ws + WS_CTL, 0, CTL_ZERO_BYTES, stream);
    Args a{};
    for (int i = 0; i < 15; ++i) a.in[i] = (const float*)d_in[i];
    a.out = (float*)d_out; a.ws = (unsigned char*)d_ws;
    hipLaunchKernelGGL(fwd_megakernel, dim3(grid), dim3(NWAVES * 64), LDS_BYTES, stream, a);
}
```

```cpp
#include <hip/hip_runtime.h>
#include <cstdio>
#include <cstdint>
namespace pg8 {
#define PG8_LAS __attribute__((address_space(3)))
typedef unsigned short bf16_t;
typedef short bf16x8 __attribute__((ext_vector_type(8)));
typedef float f32x4 __attribute__((ext_vector_type(4)));
typedef unsigned u32x4 __attribute__((ext_vector_type(4)));
constexpr int BM = 256, BK = 64, HALF = 128, HTB = HALF * BK * 2  , STAGE_BYTES = 8 * HTB, NXCD = 8, WGM = 8;

__host__ __device__ __forceinline__ int lds_byte(int r, int c) { const int st = (r >> 4) * 2 + (c >> 5), rr = r & 15, cc = c & 31, ob = rr * 64 + cc * 2; return st * 1024 + (ob ^ (((ob >> 9) & 1) << 5)); }
__host__ __device__ __forceinline__ void stage_rc(int b, int& R, int& C) { const int st = b / 1024, sb = b % 1024, swz = sb ^ (((sb >> 9) & 1) << 5); R = (st >> 1) * 16 + swz / 64; C = (st & 1) * 32 + (swz % 64) / 2; }
__host__ __device__ __forceinline__ int perm32(int rho) { const int n = rho >> 4, i = rho & 15; return 8 * (i >> 2) + 4 * n + (i & 3); }

struct Unit { int pm, pn; };
struct Gemm { const bf16_t* A; const bf16_t* Bt; int M, N, K; };

struct StaticOrder {
    int nM, nN, nwg, G, c;
    __host__ __device__ void init(int M, int N, int G_, int c_) { nM = M / BM; nN = N / BM; nwg = nM * nN; G = G_; c = c_; }
    __host__ __device__ bool next(int i, Unit& u) const {
        const long L = (long)i * G + c; if (L >= nwg) return false;
        int wgid = (int)L; { const int q = nwg / NXCD, r = nwg % NXCD, xcd = wgid % NXCD, off = wgid / NXCD; wgid = (xcd < r ? xcd * (q + 1) : r * (q + 1) + (xcd - r) * q) + off; }
        const int nig = WGM * nN, gid = wgid / nig, fm = gid * WGM, gsz = (nM - fm) < WGM ? (nM - fm) : WGM;
        u.pm = fm + ((wgid % nig) % gsz); u.pn = (wgid % nig) / gsz; return true;
    }
    __device__ __forceinline__ void a_ready(const Unit&) const {}
    __device__ __forceinline__ void done(const Unit&) const {}
};
__device__ __forceinline__ unsigned cvt_pk_bf16(float lo, float hi) { unsigned r; asm volatile("v_cvt_pk_bf16_f32 %0, %1, %2" : "=v"(r) : "v"(lo), "v"(hi)); return r; }
typedef unsigned u32x2 __attribute__((ext_vector_type(2)));
constexpr float C2 = 0.125f * 1.4426950408889634f;
__device__ __forceinline__ float sigmoid_f(float v) { return __builtin_amdgcn_rcpf(1.0f + __builtin_amdgcn_exp2f(-1.4426950408889634f * v)); }
__device__ __forceinline__ f32x4 bf2_to_f4(unsigned a, unsigned b) { f32x4 r; r[0] = __uint_as_float(a << 16); r[1] = __uint_as_float(a & 0xffff0000u); r[2] = __uint_as_float(b << 16); r[3] = __uint_as_float(b & 0xffff0000u); return r; }

struct EpiInProj {
    static constexpr bool PERM = true, AFTER_DRAIN = false, HAS_MID = false;
    bf16_t *QA, *KA, *VA, *QB, *KB, *VB, *GA, *GB; const float* cs; const float *qna, *kna, *qnb, *knb;
    __device__ __forceinline__ void operator()(const f32x4 (&acc)[2][2][4][2], const Unit& u, int wr, int wc, int fr, int fq) const {
        const int pn = u.pn;
        bf16_t* base; int pitch, col, mode; const float* gain = qna; float scale = 1.f;
        if (pn < 3)        { base = QA; pitch = 768; col = (pn * 4 + wc) * 64; mode = 1; gain = qna; scale = C2; }
        else if (pn < 6)   { base = KA; pitch = 768; col = ((pn - 3) * 4 + wc) * 64; mode = 1; gain = kna; }
        else if (pn < 9)   { base = VA; pitch = 768; col = ((pn - 6) * 4 + wc) * 64; mode = 0; }
        else if (pn < 11)  { base = QB; pitch = 512; col = ((pn - 9) * 4 + wc) * 64; mode = 1; gain = qnb; scale = C2; }
        else if (pn == 11) { if (wc < 2) { base = KB; pitch = 128; col = wc * 64; mode = 1; gain = knb; } else { base = VB; pitch = 128; col = (wc - 2) * 64; mode = 0; } }
        else               { base = GA; pitch = 1024; col = (pn - 12) * 128 + wc * 32; mode = 2; }
        const int row0 = u.pm * BM + wr * 64 + fr;
        if (mode == 1) {
            f32x4 g[2][2];
#pragma unroll
            for (int bj = 0; bj < 2; ++bj)
#pragma unroll
                for (int n = 0; n < 2; ++n) g[bj][n] = *(const f32x4*)(gain + 32 * bj + 8 * fq + 4 * n) * scale;
#pragma unroll
            for (int ai = 0; ai < 2; ++ai)
#pragma unroll
                for (int m = 0; m < 4; ++m) {
                    const int row = row0 + ai * HALF + m * 16;
                    const float* csr = cs + (size_t)row * 16;
                    const f32x4 c0 = *(const f32x4*)(csr), c1 = *(const f32x4*)(csr + 4), s0 = *(const f32x4*)(csr + 8), s1 = *(const f32x4*)(csr + 12);
                    float ss = 0.f;
#pragma unroll
                    for (int bj = 0; bj < 2; ++bj)
#pragma unroll
                        for (int n = 0; n < 2; ++n) { const f32x4 v = acc[ai][bj][m][n]; ss += (v[0] * v[0] + v[1] * v[1]) + (v[2] * v[2] + v[3] * v[3]); }
                    ss += __shfl_xor(ss, 16); ss += __shfl_xor(ss, 32);
                    const float rinv = rsqrtf(ss * (1.0f / 64.0f) + 1e-6f);
                    f32x4 y[2][2];
#pragma unroll
                    for (int bj = 0; bj < 2; ++bj)
#pragma unroll
                        for (int n = 0; n < 2; ++n) y[bj][n] = acc[ai][bj][m][n] * rinv * g[bj][n];
                    f32x4 p0, p1;
#pragma unroll
                    for (int i = 0; i < 4; ++i) { p0[i] = __shfl_xor(y[0][0][i], 16); p1[i] = __shfl_xor(y[0][1][i], 16); }
                    if (fq == 0) { y[0][0] = y[0][0] * c0 - p0 * s0; y[0][1] = y[0][1] * c1 - p1 * s1; }
                    else if (fq == 1) { y[0][0] = y[0][0] * c0 + p0 * s0; y[0][1] = y[0][1] * c1 + p1 * s1; }
                    bf16_t* rowp = base + (size_t)row * pitch + col + 8 * fq;
#pragma unroll
                    for (int bj = 0; bj < 2; ++bj) { u32x4 w; w.x = cvt_pk_bf16(y[bj][0][0], y[bj][0][1]); w.y = cvt_pk_bf16(y[bj][0][2], y[bj][0][3]); w.z = cvt_pk_bf16(y[bj][1][0], y[bj][1][1]); w.w = cvt_pk_bf16(y[bj][1][2], y[bj][1][3]);
                        *(u32x4*)(rowp + 32 * bj) = w; }
                }
        } else if (mode == 2) {
#pragma unroll
            for (int ai = 0; ai < 2; ++ai)
#pragma unroll
                for (int m = 0; m < 4; ++m) {
                    const size_t off = (size_t)(row0 + ai * HALF + m * 16) * 1024 + col + 8 * fq;
                    f32x4 r0, r1, b0, b1;
#pragma unroll
                    for (int i = 0; i < 4; ++i) { b0[i] = fmaxf(sigmoid_f(acc[ai][1][m][0][i]), 8.673617379884035e-19f); b1[i] = fmaxf(sigmoid_f(acc[ai][1][m][1][i]), 8.673617379884035e-19f);
                        r0[i] = sigmoid_f(acc[ai][0][m][0][i]) * __builtin_amdgcn_rcpf(b0[i]); r1[i] = sigmoid_f(acc[ai][0][m][1][i]) * __builtin_amdgcn_rcpf(b1[i]); }
                    u32x4 w; w.x = cvt_pk_bf16(r0[0], r0[1]); w.y = cvt_pk_bf16(r0[2], r0[3]); w.z = cvt_pk_bf16(r1[0], r1[1]); w.w = cvt_pk_bf16(r1[2], r1[3]);
                    *(u32x4*)(GA + off) = w;
                    w.x = cvt_pk_bf16(b0[0], b0[1]); w.y = cvt_pk_bf16(b0[2], b0[3]); w.z = cvt_pk_bf16(b1[0], b1[1]); w.w = cvt_pk_bf16(b1[2], b1[3]);
                    *(u32x4*)(GB + off) = w;
                }
        } else {
#pragma unroll
            for (int ai = 0; ai < 2; ++ai)
#pragma unroll
                for (int m = 0; m < 4; ++m) {
                    const int row = row0 + ai * HALF + m * 16;
                    bf16_t* rowp = base + (size_t)row * pitch + col + 8 * fq;
#pragma unroll
                    for (int bj = 0; bj < 2; ++bj) { const f32x4 v0 = acc[ai][bj][m][0], v1 = acc[ai][bj][m][1];
                        u32x4 w; w.x = cvt_pk_bf16(v0[0], v0[1]); w.y = cvt_pk_bf16(v0[2], v0[3]); w.z = cvt_pk_bf16(v1[0], v1[1]); w.w = cvt_pk_bf16(v1[2], v1[3]);
                        *(u32x4*)(rowp + 32 * bj) = w; }
                }
        }
    }
};
struct EpiMerge {
    static constexpr bool PERM = true, AFTER_DRAIN = false, HAS_MID = true;
    const bf16_t* GA; const bf16_t* GB; bf16_t* MIX; int tmid;
    __device__ __forceinline__ void mid(f32x4 (&acc)[2][2][4][2], const Unit& u, int wr, int wc, int fr, int fq) const {
        unsigned base = (unsigned)((u.pm * BM + wr * 64 + fr) * 1024 + u.pn * BM + wc * 32 + 8 * fq);
        asm volatile("" : "+v"(base));
        u32x4 rw[2][4][2];
#pragma unroll
        for (int ai = 0; ai < 2; ++ai)
#pragma unroll
            for (int m = 0; m < 4; ++m)
#pragma unroll
                for (int bj = 0; bj < 2; ++bj) rw[ai][m][bj] = *(const u32x4*)(GA + base + (unsigned)((ai * HALF + m * 16) * 1024 + bj * HALF));
#pragma unroll
        for (int ai = 0; ai < 2; ++ai)
#pragma unroll
            for (int m = 0; m < 4; ++m)
#pragma unroll
                for (int bj = 0; bj < 2; ++bj) { acc[ai][bj][m][0] *= bf2_to_f4(rw[ai][m][bj].x, rw[ai][m][bj].y); acc[ai][bj][m][1] *= bf2_to_f4(rw[ai][m][bj].z, rw[ai][m][bj].w); }
    }
    __device__ __forceinline__ void operator()(const f32x4 (&acc)[2][2][4][2], const Unit& u, int wr, int wc, int fr, int fq) const {
        const int row0 = u.pm * BM + wr * 64 + fr, col0 = u.pn * BM + wc * 32 + 8 * fq;
#pragma unroll
        for (int ai = 0; ai < 2; ++ai)
#pragma unroll
            for (int m = 0; m < 4; ++m) { const size_t off = (size_t)(row0 + ai * HALF + m * 16) * 1024 + col0;
#pragma unroll
                for (int bj = 0; bj < 2; ++bj) { const u32x4 gb = *(const u32x4*)(GB + off + bj * HALF);
                    const f32x4 v0 = acc[ai][bj][m][0] * bf2_to_f4(gb.x, gb.y), v1 = acc[ai][bj][m][1] * bf2_to_f4(gb.z, gb.w);
                    u32x4 w; w.x = cvt_pk_bf16(v0[0], v0[1]); w.y = cvt_pk_bf16(v0[2], v0[3]); w.z = cvt_pk_bf16(v1[0], v1[1]); w.w = cvt_pk_bf16(v1[2], v1[3]);
                    *(u32x4*)(MIX + off + bj * HALF) = w; } }
    }
};
struct PairOrder {
    int v;
    __device__ __forceinline__ bool next(int i, Unit& u) const { if (i >= 2) return false; u.pm = v >> 1; u.pn = 2 * (v & 1) + i; return true; }
    __device__ __forceinline__ void a_ready(const Unit&) const {}
    __device__ __forceinline__ void done(const Unit&) const {}
};
struct EpiOutProj {
    static constexpr bool PERM = false, AFTER_DRAIN = false, HAS_MID = false;
    const float* X; float* OUT; bf16_t* XN; float* SS;
    __device__ __forceinline__ void operator()(const f32x4 (&acc)[2][2][4][2], const Unit& u, int wr, int wc, int fr, int fq) const {
        const int row0 = u.pm * BM + wr * 64 + fr, col0 = u.pn * BM + wc * 32 + 4 * fq;
#pragma unroll
        for (int ai = 0; ai < 2; ++ai)
#pragma unroll
            for (int m = 0; m < 4; ++m) { const int row = row0 + ai * HALF + m * 16; const size_t off = (size_t)row * 1024 + col0; float ss = 0.f;
#pragma unroll
                for (int bj = 0; bj < 2; ++bj)
#pragma unroll
                    for (int n = 0; n < 2; ++n) { const f32x4 v = *(const f32x4*)(X + off + bj * HALF + n * 16) + acc[ai][bj][m][n];
                        *(f32x4*)(OUT + off + bj * HALF + n * 16) = v; ss += (v[0] * v[0] + v[1] * v[1]) + (v[2] * v[2] + v[3] * v[3]);
                        u32x2 w; w.x = cvt_pk_bf16(v[0], v[1]); w.y = cvt_pk_bf16(v[2], v[3]); *(u32x2*)(XN + off + bj * HALF + n * 16) = w; }
                ss += __shfl_xor(ss, 16); ss += __shfl_xor(ss, 32);
                if (fq == 0) SS[(size_t)row * 16 + u.pn * 4 + wc] = ss; }
    }
};
struct EpiUp {
    static constexpr bool PERM = true, AFTER_DRAIN = false, HAS_MID = false;
    const float* SS; bf16_t* H;
    __device__ __forceinline__ void operator()(const f32x4 (&acc)[2][2][4][2], const Unit& u, int wr, int wc, int fr, int fq) const {
        const int row0 = u.pm * BM + wr * 64 + fr, col0 = u.pn * BM + wc * 32 + 8 * fq;
#pragma unroll
        for (int ai = 0; ai < 2; ++ai)
#pragma unroll
            for (int m = 0; m < 4; ++m) { const int row = row0 + ai * HALF + m * 16;
                const f32x4 a = *(const f32x4*)(SS + (size_t)row * 16), b = *(const f32x4*)(SS + (size_t)row * 16 + 4), c = *(const f32x4*)(SS + (size_t)row * 16 + 8), d = *(const f32x4*)(SS + (size_t)row * 16 + 12);
                const f32x4 s4 = (a + b) + (c + d); const float r = rsqrtf(((s4[0] + s4[1]) + (s4[2] + s4[3])) * (1.0f / 1024.0f) + 1e-6f);
                bf16_t* rowp = H + (size_t)row * 4096 + col0;
#pragma unroll
                for (int bj = 0; bj < 2; ++bj) { f32x4 v0 = acc[ai][bj][m][0] * r, v1 = acc[ai][bj][m][1] * r;
#pragma unroll
                    for (int i = 0; i < 4; ++i) { v0[i] = fmaxf(v0[i], 0.f); v0[i] *= v0[i]; v1[i] = fmaxf(v1[i], 0.f); v1[i] *= v1[i]; }
                    u32x4 w; w.x = cvt_pk_bf16(v0[0], v0[1]); w.y = cvt_pk_bf16(v0[2], v0[3]); w.z = cvt_pk_bf16(v1[0], v1[1]); w.w = cvt_pk_bf16(v1[2], v1[3]);
                    *(u32x4*)(rowp + bj * HALF) = w; } }
    }
};
struct EpiDown {
    static constexpr bool PERM = false, AFTER_DRAIN = false, HAS_MID = false;
    const float* X1; float* OUT;
    __device__ __forceinline__ void operator()(const f32x4 (&acc)[2][2][4][2], const Unit& u, int wr, int wc, int fr, int fq) const {
        const int row0 = u.pm * BM + wr * 64 + fr, col0 = u.pn * BM + wc * 32 + 4 * fq;
#pragma unroll
        for (int ai = 0; ai < 2; ++ai)
#pragma unroll
            for (int m = 0; m < 4; ++m) { const size_t off = (size_t)(row0 + ai * HALF + m * 16) * 1024 + col0;
#pragma unroll
                for (int bj = 0; bj < 2; ++bj)
#pragma unroll
                    for (int n = 0; n < 2; ++n) { *(f32x4*)(OUT + off + bj * HALF + n * 16) = *(const f32x4*)(X1 + off + bj * HALF + n * 16) + acc[ai][bj][m][n]; } }
    }
};
template <class Epi, class Sched, bool ALIGN_EPI = false, bool SP2 = false>
__device__ __forceinline__ void gemm_phase(PG8_LAS unsigned char* lds, const Gemm g, const Sched& S, const Epi& E, const int wave_in  ) {
    int tid_; asm volatile("v_mbcnt_lo_u32_b32 %0, -1, 0\n\tv_mbcnt_hi_u32_b32 %0, -1, %0" : "=v"(tid_)); tid_ += wave_in * 64;
    const int tid = tid_, wid = wave_in, lane = tid & 63, wr = wid >> 2, wc = wid & 3, fr = lane & 15, fq = lane >> 4;
    const int K = g.K, nt = K / BK;
    unsigned voffA[2], voffB[2];
#pragma unroll
    for (int i = 0; i < 2; ++i) { int R, C; stage_rc(tid * 16 + i * 8192, R, C); const int Rb = Epi::PERM ? ((R & ~31) + perm32(R & 31)) : R;
        voffA[i] = (unsigned)(R * K + C) * 2u; voffB[i] = (unsigned)(Rb * K + C) * 2u; }
    const size_t kstep = (size_t)(BK * 2);
    const size_t hstep = (size_t)HALF * K * 2;
    const size_t tstep = 2 * hstep;
    const unsigned ldsw = (unsigned)wid * 1024u;
    const int aoff = lds_byte(wr * 64 + fr, fq * 8), boff = lds_byte(wc * 32 + fr, fq * 8);
#define PG8_SA(b, h) (((b) * 2 + (h)) * HTB)
#define PG8_SB(b, h) ((4 + (b) * 2 + (h)) * HTB)
#define PG8_STAGE(bufoff, gbase, voff) do { _Pragma("unroll") for (int _i = 0; _i < 2; ++_i) \
        __builtin_amdgcn_global_load_lds((const unsigned*)((const char*)(gbase) + (voff)[_i]), (PG8_LAS unsigned*)(lds + (bufoff) + ldsw + _i * 8192), 16, 0, 0); } while (0)
#define PG8_LDA(dst, b, h) do { _Pragma("unroll") for (int m = 0; m < 4; ++m) _Pragma("unroll") for (int k = 0; k < 2; ++k) dst[m][k] = *(const PG8_LAS bf16x8*)(lds + PG8_SA(b, h) + aoff + m * 2048 + k * 1024); } while (0)
#define PG8_LDB(dst, b, h) do { _Pragma("unroll") for (int n = 0; n < 2; ++n) _Pragma("unroll") for (int k = 0; k < 2; ++k) dst[n][k] = *(const PG8_LAS bf16x8*)(lds + PG8_SB(b, h) + boff + n * 2048 + k * 1024); } while (0)
#define PG8_MMA(ai, bj, At, Bt) do { __builtin_amdgcn_s_setprio(1); _Pragma("unroll") for (int m = 0; m < 4; ++m) _Pragma("unroll") for (int n = 0; n < 2; ++n) _Pragma("unroll") for (int k = 0; k < 2; ++k) \
        acc[ai][bj][m][n] = __builtin_amdgcn_mfma_f32_16x16x32_bf16(Bt[n][k], At[m][k], acc[ai][bj][m][n], 0, 0, 0); __builtin_amdgcn_s_setprio(0); } while (0)
#define PG8_WAIT_V(n) asm volatile("s_waitcnt vmcnt(" #n ")" ::: "memory")
#define PG8_WAIT_L(n) asm volatile("s_waitcnt lgkmcnt(" #n ")" ::: "memory")
#define PG8_BAR __builtin_amdgcn_s_barrier()
#define PG8_SCHED __builtin_amdgcn_sched_barrier(0)
    Unit cur, nxt; int ui = 0;
    if (!S.next(0, cur)) return;
    f32x4 acc[2][2][4][2];
#pragma unroll
    for (int a = 0; a < 2; ++a)
#pragma unroll
        for (int b = 0; b < 2; ++b)
#pragma unroll
            for (int m = 0; m < 4; ++m)
#pragma unroll
                for (int n = 0; n < 2; ++n) acc[a][b][m][n] = (f32x4){0.f, 0.f, 0.f, 0.f};
    bf16x8 At[4][2], B0[2][2], B1[2][2];
    const char* cA = (const char*)g.A + (size_t)cur.pm * tstep; const char* cB = (const char*)g.Bt + (size_t)cur.pn * tstep;
    S.a_ready(cur);
    if constexpr (SP2) {
        PG8_STAGE(PG8_SB(0, 0), cB, voffB); PG8_STAGE(PG8_SB(0, 1), cB + hstep, voffB); PG8_STAGE(PG8_SA(0, 0), cA, voffA); PG8_STAGE(PG8_SA(0, 1), cA + hstep, voffA);
        if (wr == 1) PG8_BAR;
        PG8_WAIT_V(2); PG8_BAR;
        PG8_STAGE(PG8_SB(1, 0), cB + kstep, voffB); PG8_STAGE(PG8_SA(1, 0), cA + kstep, voffA); PG8_STAGE(PG8_SB(1, 1), cB + hstep + kstep, voffB);
        PG8_WAIT_V(6); PG8_BAR;
    } else {
        PG8_STAGE(PG8_SB(0, 0), cB, voffB); PG8_STAGE(PG8_SA(0, 0), cA, voffA); PG8_STAGE(PG8_SB(0, 1), cB + hstep, voffB); PG8_STAGE(PG8_SA(0, 1), cA + hstep, voffA);
        if (wr == 1) PG8_BAR;
        PG8_WAIT_V(4); PG8_BAR;
        PG8_STAGE(PG8_SB(1, 0), cB + kstep, voffB); PG8_STAGE(PG8_SA(1, 0), cA + kstep, voffA); PG8_STAGE(PG8_SB(1, 1), cB + hstep + kstep, voffB);
        PG8_WAIT_V(6); PG8_BAR;
    }
    for (;;) {
        const bool has_next = S.next(ui + 1, nxt);
        const char* nA = has_next ? (const char*)g.A + (size_t)nxt.pm * tstep : cA; const char* nB = has_next ? (const char*)g.Bt + (size_t)nxt.pn * tstep : cB;
        for (int t = 0; t < nt; t += 2) {
            if constexpr (Epi::HAS_MID) { if (t == E.tmid) E.mid(acc, cur, wr, wc, fr, fq); }
            const bool last = (t == nt - 2);
            const char* a1 = cA + (size_t)(t + 1) * kstep;
            const char* a2 = last ? nA : cA + (size_t)(t + 2) * kstep; const char* b2 = last ? nB : cB + (size_t)(t + 2) * kstep;
            const char* a3 = a2 + kstep; const char* b3 = b2 + kstep;
            if (last && has_next) S.a_ready(nxt);
            if constexpr (SP2) {
            PG8_LDB(B0, 0, 0); PG8_LDB(B1, 0, 1); PG8_SCHED; PG8_LDA(At, 0, 0); PG8_STAGE(PG8_SA(1, 1), a1 + hstep, voffA);
            PG8_WAIT_V(8); PG8_WAIT_L(0); PG8_BAR; PG8_MMA(0, 0, At, B0); PG8_MMA(0, 1, At, B1); PG8_BAR; PG8_SCHED;
            PG8_LDA(At, 0, 1); PG8_STAGE(PG8_SB(0, 0), b2, voffB); PG8_STAGE(PG8_SB(0, 1), b2 + hstep, voffB); PG8_STAGE(PG8_SA(0, 0), a2, voffA);
            PG8_WAIT_V(8); PG8_WAIT_L(0); PG8_BAR; PG8_MMA(1, 0, At, B0); PG8_MMA(1, 1, At, B1); PG8_BAR; PG8_SCHED;
            PG8_LDB(B0, 1, 0); PG8_LDB(B1, 1, 1); PG8_SCHED; PG8_LDA(At, 1, 0); PG8_STAGE(PG8_SA(0, 1), a2 + hstep, voffA);
            PG8_WAIT_V(8); PG8_WAIT_L(0); PG8_BAR; PG8_MMA(0, 0, At, B0); PG8_MMA(0, 1, At, B1); PG8_BAR; PG8_SCHED;
            PG8_LDA(At, 1, 1); PG8_STAGE(PG8_SB(1, 0), b3, voffB); PG8_STAGE(PG8_SB(1, 1), b3 + hstep, voffB); PG8_STAGE(PG8_SA(1, 0), a3, voffA);
            PG8_WAIT_V(8); PG8_WAIT_L(0); PG8_BAR; PG8_MMA(1, 0, At, B0); PG8_MMA(1, 1, At, B1); PG8_BAR; PG8_SCHED;
            } else {
            PG8_LDB(B0, 0, 0); PG8_SCHED; PG8_LDA(At, 0, 0); PG8_STAGE(PG8_SA(1, 1), a1 + hstep, voffA);
            PG8_WAIT_L(8); PG8_BAR; PG8_WAIT_L(0); PG8_MMA(0, 0, At, B0); PG8_BAR; PG8_SCHED;
            PG8_LDB(B1, 0, 1); PG8_STAGE(PG8_SB(0, 0), b2, voffB);
            PG8_BAR; PG8_WAIT_L(0); PG8_MMA(0, 1, At, B1); PG8_BAR;
            PG8_LDA(At, 0, 1); PG8_STAGE(PG8_SA(0, 0), a2, voffA);
            PG8_BAR; PG8_WAIT_L(0); PG8_MMA(1, 0, At, B0); PG8_BAR; PG8_SCHED;
            PG8_STAGE(PG8_SB(0, 1), b2 + hstep, voffB);
            PG8_WAIT_V(6); PG8_BAR; PG8_MMA(1, 1, At, B1); PG8_BAR;
            PG8_LDB(B0, 1, 0); PG8_SCHED; PG8_LDA(At, 1, 0); PG8_STAGE(PG8_SA(0, 1), a2 + hstep, voffA);
            PG8_WAIT_L(8); PG8_BAR; PG8_WAIT_L(0); PG8_MMA(0, 0, At, B0); PG8_BAR; PG8_SCHED;
            PG8_LDB(B1, 1, 1); PG8_STAGE(PG8_SB(1, 0), b3, voffB);
            PG8_BAR; PG8_WAIT_L(0); PG8_MMA(0, 1, At, B1); PG8_BAR;
            PG8_LDA(At, 1, 1); PG8_STAGE(PG8_SA(1, 0), a3, voffA);
            PG8_BAR; PG8_WAIT_L(0); PG8_MMA(1, 0, At, B0); PG8_BAR; PG8_SCHED;
            PG8_STAGE(PG8_SB(1, 1), b3 + hstep, voffB);
            PG8_WAIT_V(6); PG8_BAR; PG8_MMA(1, 1, At, B1); PG8_BAR;
            }
        }
        if constexpr (ALIGN_EPI) { if (wr == 0) PG8_BAR; }
        if constexpr (!Epi::AFTER_DRAIN) { E(acc, cur, wr, wc, fr, fq); S.done(cur); }
        if (!has_next) break;
#pragma unroll
        for (int a = 0; a < 2; ++a)
#pragma unroll
            for (int b = 0; b < 2; ++b)
#pragma unroll
                for (int m = 0; m < 4; ++m)
#pragma unroll
                    for (int n = 0; n < 2; ++n) acc[a][b][m][n] = (f32x4){0.f, 0.f, 0.f, 0.f};
        cur = nxt; cA = nA; cB = nB; ++ui;
        if constexpr (ALIGN_EPI) { if (wr == 1) PG8_BAR; }
    }
    PG8_WAIT_V(0);
    if constexpr (!ALIGN_EPI) { if (wr == 0) PG8_BAR; }
    PG8_BAR;
    if constexpr (Epi::AFTER_DRAIN) { E.fused(acc, cur, wr, wc, fr, fq, lds, wid, lane); S.done(cur); }
#undef PG8_SA
#undef PG8_SB
#undef PG8_STAGE
#undef PG8_LDA
#undef PG8_LDB
#undef PG8_MMA
#undef PG8_WAIT_V
#undef PG8_WAIT_L
#undef PG8_BAR
#undef PG8_SCHED
}
}
#define GAS __attribute__((address_space(1)))
#define LAS __attribute__((address_space(3)))
typedef unsigned short bf16;
typedef unsigned v4u __attribute__((ext_vector_type(4)));
typedef unsigned v2u __attribute__((ext_vector_type(2)));
typedef float f32x4 __attribute__((ext_vector_type(4)));
typedef float f32x16 __attribute__((ext_vector_type(16)));
typedef short bf16x8 __attribute__((ext_vector_type(8)));
typedef short s16x4 __attribute__((ext_vector_type(4)));
typedef GAS unsigned gu32;
#define RLX_AGENT __ATOMIC_RELAXED, __HIP_MEMORY_SCOPE_AGENT
#define LDS_WAIT() asm volatile("s_waitcnt lgkmcnt(0)" ::: "memory")
#define VM_WAIT() asm volatile("s_waitcnt vmcnt(0)" ::: "memory")
__device__ __forceinline__ unsigned f2bf(float f) { unsigned u = __builtin_bit_cast(unsigned, f); return (u + 0x7fffu + ((u >> 16) & 1u)) >> 16; }
__device__ __forceinline__ unsigned pk2(float lo, float hi) { return f2bf(lo) | (f2bf(hi) << 16); }
__device__ __forceinline__ int mk_lane_() { int l; asm volatile("v_mbcnt_lo_u32_b32 %0, -1, 0\n\tv_mbcnt_hi_u32_b32 %0, -1, %0" : "=v"(l)); return l; }
#define MK_LANE() mk_lane_()
#define XB_TMO      128
#define XB_XCNT(j)  (256  + 64 * (j))
#define XB_XSUB(j)  (1280 + 64 * (j))
#define XB_XGEN(j)  (2304 + 64 * (j))
#define XB_TOP      3328
#define XB_TOPGEN   3392
#define XCD_BAR_WORDS 3456
#define XB_SPIN_CAP (1u << 18)

__device__ __forceinline__ unsigned xb_ld(unsigned* p)              { return __hip_atomic_load(p, __ATOMIC_RELAXED, __HIP_MEMORY_SCOPE_AGENT); }
__device__ __forceinline__ unsigned xb_add(unsigned* p, unsigned v) { return __hip_atomic_fetch_add(p, v, __ATOMIC_RELAXED, __HIP_MEMORY_SCOPE_AGENT); }
__device__ __forceinline__ unsigned xb_xcc_id() { return (unsigned)__builtin_amdgcn_s_getreg((3 << 11) | 20) & 0xFu; }
#define XB_SPIN(cond, bar) do { unsigned _sp = 0; while (cond) { __builtin_amdgcn_s_sleep(1); \
    if ((++_sp & 255u) == 0u) { if (xb_ld(&(bar)[XB_TMO])) break; if (_sp > XB_SPIN_CAP) { atomicAdd(&(bar)[XB_TMO], 1u); break; } } } } while (0)

struct XcdBarrier {
    unsigned* bar; unsigned x; int wave;
    volatile LAS unsigned* st;
};

__device__ __forceinline__ XcdBarrier xcd_barrier_post(unsigned* bar, volatile LAS unsigned* st, int wave) {
    XcdBarrier b; b.bar = bar; b.x = xb_xcc_id(); b.st = st; b.wave = wave;
    if (wave == 0 && MK_LANE() == 0) (void)xb_add(&bar[XB_XCNT(b.x)], 1u);
    return b;
}
__device__ __forceinline__ void xcd_barrier_complete(unsigned* bar, unsigned x, unsigned& nloc, unsigned& nx) {
    const unsigned G = gridDim.x * gridDim.y * gridDim.z;
    unsigned sum, cnt, mine, sp = 0u;
    for (;;) {
        sum = 0u; cnt = 0u; mine = 0u;
#pragma unroll
        for (unsigned j = 0; j < 16; ++j) { const unsigned c = xb_ld(&bar[XB_XCNT(j)]); sum += c; cnt += (c > 0u) ? 1u : 0u; mine = (j == x) ? c : mine; }
        if (sum == G) break;
        __builtin_amdgcn_s_sleep(1);
        if ((++sp & 255u) == 0u) { if (xb_ld(&bar[XB_TMO])) break; if (sp > XB_SPIN_CAP) { atomicAdd(&bar[XB_TMO], 1u); break; } }
    }
    nloc = mine > 0u ? mine : 1u; nx = cnt > 0u ? cnt : 1u;
}

__device__ __forceinline__ void xcd_barrier(const XcdBarrier& b) {
    asm volatile("s_waitcnt vmcnt(0)" ::: "memory");
    __syncthreads();
    if (b.wave == 0 && MK_LANE() == 0) {
        unsigned* bar = b.bar;
        __builtin_amdgcn_s_waitcnt(0);
        unsigned nloc = b.st[0], nx = b.st[1];
        if (nloc == 0u) { xcd_barrier_complete(bar, b.x, nloc, nx); b.st[0] = nloc; b.st[1] = nx; }
        const unsigned old = xb_add(&bar[XB_XSUB(b.x)], 1u);
        const unsigned gen = old / nloc;
        if (old + 1u == (gen + 1u) * nloc) {
            __builtin_amdgcn_fence(__ATOMIC_RELEASE, "agent");
            asm volatile("s_waitcnt vmcnt(0)" ::: "memory");
            const unsigned og = xb_add(&bar[XB_TOP], 1u);
            const unsigned tg = og / nx;
            if (og + 1u == (tg + 1u) * nx) xb_add(&bar[XB_TOPGEN], 1u);
            else XB_SPIN(xb_ld(&bar[XB_TOPGEN]) == tg, bar);
            __builtin_amdgcn_fence(__ATOMIC_ACQUIRE, "agent");
            xb_add(&bar[XB_XGEN(b.x)], 1u);
            asm volatile("s_waitcnt vmcnt(0)" ::: "memory");
        } else {
            XB_SPIN(xb_ld(&bar[XB_XGEN(b.x)]) == gen, bar);
            __builtin_amdgcn_fence(__ATOMIC_ACQUIRE, "agent");
            asm volatile("s_waitcnt vmcnt(0)" ::: "memory");
        }
    }
    __syncthreads();
}
#ifndef MK_REPEAT
#define MK_REPEAT -1
#endif
#define REPS(k) ((MK_REPEAT == (k)) ? 2 : 1)
constexpr int NWAVES = 8;
constexpr int BATCH = 8, SEQ = 4096, DM = 1024, FF = 4096, INW = 5120;
constexpr int M = BATCH * SEQ;
constexpr size_t MiB = 1u << 20;
constexpr size_t WS_CTL = 0, CTL_ZERO_BYTES = 64 * 1024;
constexpr size_t WS_WIN = 2 * MiB, WS_WA = 12 * MiB, WS_WB = 13 * MiB, WS_WO = 14 * MiB, WS_W1 = 16 * MiB, WS_W2 = 24 * MiB;
constexpr size_t WS_CS = 32 * MiB, WS_SS = 34 * MiB, WS_LSE = 36 * MiB;
constexpr size_t WS_XN = 40 * MiB;
constexpr size_t WS_QA = 104 * MiB, WS_KA = 152 * MiB, WS_VA = 200 * MiB, WS_QB = 248 * MiB, WS_KB = 280 * MiB, WS_VB = 288 * MiB;
constexpr size_t WS_GA = 296 * MiB, WS_GB = 360 * MiB, WS_OAB = 424 * MiB, WS_END = 472 * MiB;
constexpr size_t WS_MIX = 152 * MiB;
constexpr size_t WS_H = 104 * MiB;
static_assert(WS_H + (size_t)M * FF * 2 <= WS_GB, "hidden overlay");
constexpr int CW_BAR = 1024;
constexpr int RING_OFF = 0, RING_BYTES = 131072, LDSCTL_OFF = RING_BYTES, MISC_OFF = LDSCTL_OFF + 320, LDS_BYTES = 147456;

struct Args { const float* in[15]; float* out; unsigned char* ws; };

__device__ __forceinline__ float wave_sum(float v) {
#pragma unroll
    for (int o = 1; o < 64; o <<= 1) v += __shfl_xor(v, o);
    return v;
}
__device__ __forceinline__ void p0_transpose_item(const float* W, int K, int N, bf16* WT, int ldt  , bool permute, const float* kscale, LAS float* scr, int item, int lane) {
    const int nblk = N / 32, kb = item / nblk, nb = item % nblk, k0 = 64 * kb, n0 = 32 * nb;
#pragma unroll 8
    for (int i = 0; i < 32; ++i) { const int kk = 2 * i + (lane >> 5); float v = W[(size_t)(k0 + kk) * N + n0 + (lane & 31)]; if (kscale) v *= kscale[k0 + kk]; scr[kk * 33 + (lane & 31)] = v; }
    LDS_WAIT(); asm volatile("" ::: "memory");
    const int c = lane & 7;
    int p0 = n0;
    if (permute) { if (n0 < 3072) p0 = (n0 & ~255) + 128 * ((n0 >> 5) & 1) + 32 * ((n0 >> 6) & 3);
                   else { const int ch = (n0 - 3072) & 1023; p0 = 3072 + 256 * (ch >> 7) + ((n0 >= 4096) ? 128 : 0) + (ch & 127); } }
#pragma unroll
    for (int j = 0; j < 4; ++j) { const int n = (lane >> 3) + 8 * j; const LAS float* s = scr + (8 * c) * 33 + n;
        v4u o; o.x = pk2(s[0 * 33], s[1 * 33]); o.y = pk2(s[2 * 33], s[3 * 33]); o.z = pk2(s[4 * 33], s[5 * 33]); o.w = pk2(s[6 * 33], s[7 * 33]);
        *(GAS v4u*)(WT + (size_t)(p0 + n) * ldt + k0 + 8 * c) = o; }
    LDS_WAIT(); asm volatile("" ::: "memory");
}
__device__ __forceinline__ void rms_row_to_bf16(const float* xrow, const float* g, bf16* orow, int lane) {
    const GAS f32x4* xr = (const GAS f32x4*)xrow + lane; const GAS f32x4* gr = (const GAS f32x4*)g + lane;
    f32x4 v[4]; float s = 0.f;
#pragma unroll
    for (int j = 0; j < 4; ++j) { v[j] = xr[64 * j]; s += (v[j].x * v[j].x + v[j].y * v[j].y) + (v[j].z * v[j].z + v[j].w * v[j].w); }
    const float r = rsqrtf(wave_sum(s) * (1.f / DM) + 1e-6f);
    GAS unsigned long long* o8 = (GAS unsigned long long*)orow + lane;
#pragma unroll
    for (int j = 0; j < 4; ++j) { const f32x4 gg = gr[64 * j]; o8[64 * j] = (unsigned long long)pk2(v[j].x * r * gg.x, v[j].y * r * gg.y) | ((unsigned long long)pk2(v[j].z * r * gg.z, v[j].w * r * gg.w) << 32); }
}

namespace att {
constexpr int K_OFF = 0, V_OFF = 384 * 128, ATT_LDS = 2 * 384 * 128;
constexpr int N_DIL_UNITS = BATCH * 12 * 16, N_SWA_UNITS = BATCH * 8 * 16, N_UNITS = N_DIL_UNITS + N_SWA_UNITS;
__device__ __forceinline__ int crow(int r, int hi) { return (r & 3) + 8 * (r >> 2) + 4 * hi; }
struct Ptrs { bf16 *QA, *KA, *VA, *QB, *KB, *VB, *OA3, *OB; float* LSE; const float* sinks; };

__device__ __forceinline__ void attn_unit(int u, const Ptrs& P, LAS unsigned char* lds, int wid) {
    int lane = MK_LANE(); asm volatile("" : "+v"(lane)); const int tid = wid * 64 + lane;
    const bf16 *Qp, *Kp, *Vp; bf16* Op; float* lsep = nullptr; long qpitch, kpitch, opitch, lpitch = 0; int i0, wlo; float sink2 = 0.f; bool has_sink = false;
    if (u < N_DIL_UNITS) {
        const int b = u / 192, rem = u % 192, head = rem >> 4, blk = rem & 15, g = head >> 2, dil = 1 << (2 * g), bps = 16 >> (2 * g), n = blk / bps, qb = blk % bps;
        const long row0 = (long)b * SEQ + n;
        Qp = P.QA + row0 * 768 + head * 64; Kp = P.KA + row0 * 768 + head * 64; Vp = P.VA + row0 * 768 + head * 64; Op = P.OA3 + row0 * 768 + head * 64;
        qpitch = 768L * dil; kpitch = 768L * dil; opitch = qpitch; lsep = P.LSE + row0 * 12 + head; lpitch = 12L * dil; i0 = qb * 256; wlo = 0;
    } else {
        const int v = u - N_DIL_UNITS, b = v >> 7, rem = v & 127, hq = rem >> 4, qb = rem & 15;
        const long row0 = (long)b * SEQ;
        Qp = P.QB + row0 * 512 + hq * 64; Kp = P.KB + row0 * 128 + (hq >> 2) * 64; Vp = P.VB + row0 * 128 + (hq >> 2) * 64; Op = P.OB + row0 * 768 + 256 + hq * 64; opitch = 768;
        qpitch = 512; kpitch = 128; i0 = qb * 256; wlo = 1; has_sink = true; sink2 = P.sinks[hq] * 1.4426950408889634f;
    }
    {
        v4u kreg[6], vreg[6];
#pragma unroll
        for (int j = 0; j < 6; ++j) { const int c = tid + 512 * j, r = c >> 3, ch = c & 7, i = i0 - 128 + r;
            if (i >= 0) { kreg[j] = *(const GAS v4u*)(Kp + (long)i * kpitch + ch * 8); vreg[j] = *(const GAS v4u*)(Vp + (long)i * kpitch + ch * 8); }
            else { kreg[j] = (v4u){0u, 0u, 0u, 0u}; vreg[j] = (v4u){0u, 0u, 0u, 0u}; } }
#pragma unroll
        for (int j = 0; j < 6; ++j) { const int c = tid + 512 * j, r = c >> 3, ch = c & 7;
            *(LAS v4u*)(lds + K_OFF + r * 128 + ((ch ^ ((r >> 1) & 7)) << 4)) = kreg[j];
            *(LAS v4u*)(lds + V_OFF + r * 128 + (ch << 4)) = vreg[j]; }
    }
    const int x = lane & 31, hi = lane >> 5;
    const long qrow = i0 + 32 * wid + x;
    bf16x8 qf[4];
#pragma unroll
    for (int ks = 0; ks < 4; ++ks) qf[ks] = *(const GAS bf16x8*)(Qp + qrow * qpitch + 16 * ks + 8 * hi);
    __syncthreads();
    f32x16 S[5];
#pragma unroll
    for (int c = 0; c < 5; ++c) {
        const int krow = 32 * wid + 32 * c + x;
        f32x16 a = {};
#pragma unroll
        for (int ks = 0; ks < 4; ++ks) { const bf16x8 kf = *(const LAS bf16x8*)(lds + K_OFF + krow * 128 + (((2 * ks + hi) ^ ((krow >> 1) & 7)) << 4));
            a = __builtin_amdgcn_mfma_f32_32x32x16_bf16(kf, qf[ks], a, 0, 0, 0); }
        S[c] = a;
    }
    const float NEG = -INFINITY;
#pragma unroll
    for (int r = 0; r < 16; ++r) { const int y = crow(r, hi); if (y < x + wlo) S[0][r] = NEG; if (y > x) S[4][r] = NEG; }
    if (i0 == 0 && wid < 4) {
#pragma unroll
        for (int c = 0; c < 4; ++c) if (c < 4 - wid) {
#pragma unroll
            for (int r = 0; r < 16; ++r) S[c][r] = NEG; }
    }
    float m = NEG;
#pragma unroll
    for (int c = 0; c < 5; ++c)
#pragma unroll
        for (int r = 0; r < 16; ++r) m = fmaxf(m, S[c][r]);
    m = fmaxf(m, __shfl_xor(m, 32));
    if (has_sink) m = fmaxf(m, sink2);
    float l = 0.f;
#pragma unroll
    for (int c = 0; c < 5; ++c)
#pragma unroll
        for (int r = 0; r < 16; ++r) { const float p = __builtin_amdgcn_exp2f(S[c][r] - m); S[c][r] = p; l += p; }
    l += __shfl_xor(l, 32);
    if (has_sink) l += __builtin_amdgcn_exp2f(sink2 - m);
    f32x16 o0 = {}, o1 = {};
    const LAS unsigned char* vb = lds + V_OFF + (32 * wid + 4 * hi + ((lane & 15) >> 2)) * 128 + (16 * ((lane >> 4) & 1) + 4 * (lane & 3)) * 2;
#pragma unroll
    for (int c = 0; c < 5; ++c)
#pragma unroll
        for (int s = 0; s < 2; ++s) {
            v4u pw; pw.x = pg8::cvt_pk_bf16(S[c][8 * s + 0], S[c][8 * s + 1]); pw.y = pg8::cvt_pk_bf16(S[c][8 * s + 2], S[c][8 * s + 3]);
            pw.z = pg8::cvt_pk_bf16(S[c][8 * s + 4], S[c][8 * s + 5]); pw.w = pg8::cvt_pk_bf16(S[c][8 * s + 6], S[c][8 * s + 7]);
            const bf16x8 pf = __builtin_bit_cast(bf16x8, pw);
            const LAS unsigned char* vp = vb + (32 * c + 16 * s) * 128;
            const s16x4 a0 = __builtin_bit_cast(s16x4, __builtin_amdgcn_ds_read_tr16_b64_v4i16((LAS s16x4*)(vp)));
            const s16x4 a1 = __builtin_bit_cast(s16x4, __builtin_amdgcn_ds_read_tr16_b64_v4i16((LAS s16x4*)(vp + 8 * 128)));
            const s16x4 b0 = __builtin_bit_cast(s16x4, __builtin_amdgcn_ds_read_tr16_b64_v4i16((LAS s16x4*)(vp + 64)));
            const s16x4 b1 = __builtin_bit_cast(s16x4, __builtin_amdgcn_ds_read_tr16_b64_v4i16((LAS s16x4*)(vp + 8 * 128 + 64)));
            const bf16x8 vf0 = (bf16x8){a0[0], a0[1], a0[2], a0[3], a1[0], a1[1], a1[2], a1[3]};
            const bf16x8 vf1 = (bf16x8){b0[0], b0[1], b0[2], b0[3], b1[0], b1[1], b1[2], b1[3]};
            o0 = __builtin_amdgcn_mfma_f32_32x32x16_bf16(vf0, pf, o0, 0, 0, 0);
            o1 = __builtin_amdgcn_mfma_f32_32x32x16_bf16(vf1, pf, o1, 0, 0, 0);
        }
    const float inv = 1.0f / l;
    bf16* orow = Op + qrow * opitch;
#pragma unroll
    for (int rg = 0; rg < 4; ++rg) {
        v2u w0, w1;
        w0.x = pg8::cvt_pk_bf16(o0[4 * rg + 0] * inv, o0[4 * rg + 1] * inv); w0.y = pg8::cvt_pk_bf16(o0[4 * rg + 2] * inv, o0[4 * rg + 3] * inv);
        w1.x = pg8::cvt_pk_bf16(o1[4 * rg + 0] * inv, o1[4 * rg + 1] * inv); w1.y = pg8::cvt_pk_bf16(o1[4 * rg + 2] * inv, o1[4 * rg + 3] * inv);
        *(GAS v2u*)(orow + 8 * rg + 4 * hi) = w0; *(GAS v2u*)(orow + 32 + 8 * rg + 4 * hi) = w1;
    }
    if (lsep && hi == 0) lsep[qrow * lpitch] = m + __builtin_amdgcn_logf(l);
    __syncthreads();
}
}

__global__ void __launch_bounds__(NWAVES * 64, 2) fwd_megakernel(Args args) {
    extern __shared__ __attribute__((aligned(16))) unsigned char lds_raw[];
    LAS unsigned char* lds = (LAS unsigned char*)lds_raw;
    volatile LAS unsigned* MISC = (volatile LAS unsigned*)(lds + MISC_OFF);
    const int wave = __builtin_amdgcn_readfirstlane((int)(threadIdx.x >> 6));
#define TID() (wave * 64 + MK_LANE())
    const int G = gridDim.x, bx = blockIdx.x, vcu = (G % 8 == 0) ? (bx % 8) * (G / 8) + bx / 8 : bx;
    unsigned char* ws = args.ws;
    gu32* ctl = (gu32*)(ws + WS_CTL);
    const float* x = args.in[0]; const int* positions = (const int*)args.in[1]; const float* ln1_g = args.in[2]; const float* w_in = args.in[3];
    const float *qna = args.in[4], *kna = args.in[5], *qnb = args.in[6], *knb = args.in[7], *sinks = args.in[8];
    const float *w_a = args.in[9], *w_b = args.in[10], *w_o = args.in[11], *ln2_g = args.in[12], *w_up = args.in[13], *w_down = args.in[14];
    float* out = args.out;
    bf16 *Win_t = (bf16*)(ws + WS_WIN), *Wab_t = (bf16*)(ws + WS_WA), *Wo_t = (bf16*)(ws + WS_WO), *W1_t = (bf16*)(ws + WS_W1), *W2_t = (bf16*)(ws + WS_W2);
    float *CS = (float*)(ws + WS_CS), *SS = (float*)(ws + WS_SS), *LSE = (float*)(ws + WS_LSE);
    bf16 *XN = (bf16*)(ws + WS_XN), *QA = (bf16*)(ws + WS_QA), *KA = (bf16*)(ws + WS_KA), *VA = (bf16*)(ws + WS_VA), *QB = (bf16*)(ws + WS_QB), *KB = (bf16*)(ws + WS_KB), *VB = (bf16*)(ws + WS_VB);
    bf16 *GA = (bf16*)(ws + WS_GA), *GB = (bf16*)(ws + WS_GB), *OAB = (bf16*)(ws + WS_OAB), *MIX = (bf16*)(ws + WS_MIX), *HB = (bf16*)(ws + WS_H);

    for (int u = TID(); u < (LDS_BYTES - LDSCTL_OFF) / 4; u += NWAVES * 64) ((LAS unsigned*)(lds + LDSCTL_OFF))[u] = 0u;
    __syncthreads();
    XcdBarrier bar = xcd_barrier_post((unsigned*)(ctl + CW_BAR), MISC + 8, wave);
    const int gw = vcu * NWAVES + wave, NGW = G * NWAVES;

    for (int rep = 0; rep < REPS(0); ++rep) {
        LAS float* scr = (LAS float*)(lds + RING_OFF + wave * 16384);
        constexpr int I_IN = (DM / 64) * (INW / 32), I_A = (256 / 64) * (DM / 32), I_B = (512 / 64) * (DM / 32), I_O = (DM / 64) * (DM / 32), I_1 = (DM / 64) * (FF / 32), I_2 = (FF / 64) * (DM / 32);
        constexpr int NITEMS = I_IN + I_A + I_B + I_O + I_1 + I_2;
        for (int it = gw; it < NITEMS; it += NGW) {
            int r = it;
            if (r < I_IN) { p0_transpose_item(w_in, DM, INW, Win_t, DM, true, nullptr, scr, r, MK_LANE()); continue; } r -= I_IN;
            if (r < I_A) { p0_transpose_item(w_a, 256, DM, Wab_t, 768, false, nullptr, scr, r, MK_LANE()); continue; } r -= I_A;
            if (r < I_B) { p0_transpose_item(w_b, 512, DM, Wab_t + 256, 768, false, nullptr, scr, r, MK_LANE()); continue; } r -= I_B;
            if (r < I_O) { p0_transpose_item(w_o, DM, DM, Wo_t, DM, false, nullptr, scr, r, MK_LANE()); continue; } r -= I_O;
            if (r < I_1) { p0_transpose_item(w_up, DM, FF, W1_t, DM, false, ln2_g, scr, r, MK_LANE()); continue; } r -= I_1;
            p0_transpose_item(w_down, FF, DM, W2_t, FF, false, nullptr, scr, r, MK_LANE());
        }
        for (int idx = (vcu * NWAVES * 64 + TID()); idx < M * 8; idx += G * NWAVES * 64) {
            const int row = idx >> 3, j = idx & 7;
            const float invf = powf(500000.0f, -(float)(2 * j) / 16.0f);
            const float ang = (float)positions[row] * invf;
            CS[(size_t)row * 16 + j] = cosf(ang); CS[(size_t)row * 16 + 8 + j] = sinf(ang);
        }
        for (int m = gw; m < M; m += NGW) rms_row_to_bf16(x + (size_t)m * DM, ln1_g, XN + (size_t)m * DM, MK_LANE());
        xcd_barrier(bar);
    }

    for (int rep = 0; rep < REPS(1); ++rep) {
        pg8::Gemm g{XN, Win_t, M, INW, DM}; pg8::StaticOrder S; S.init(M, INW, G, bx);
        pg8::EpiInProj E{QA, KA, VA, QB, KB, VB, GA, GB, CS, qna, kna, qnb, knb};
        pg8::gemm_phase<pg8::EpiInProj, pg8::StaticOrder, true, true>(lds + RING_OFF, g, S, E, wave);
        xcd_barrier(bar);
    }

    for (int rep = 0; rep < REPS(2); ++rep) {
        const bool dummy = (REPS(2) == 2) && rep == 0;
        att::Ptrs P{QA, KA, VA, QB, KB, VB, dummy ? (bf16*)out : QA, dummy ? (bf16*)out + (size_t)M * 768 : OAB, dummy ? out + (size_t)M * 768 : LSE, sinks};
        for (int u = vcu; u < att::N_UNITS; u += G) att::attn_unit(u, P, lds + RING_OFF, wave);
        xcd_barrier(bar);
    }

    for (int rep = 0; rep < REPS(4); ++rep) {
        const int pm = vcu >> 1;
        {
            const int lane = MK_LANE(); const int j = lane >> 4;
            for (int r0 = wave; r0 < 256; r0 += 8 * NWAVES) {
                float l0[8], l1[8], l2[8]; v2u a[8], b[8], c[8];
#pragma unroll
                for (int q = 0; q < 8; ++q) { const size_t t = (size_t)pm * 256 + r0 + q * NWAVES; l0[q] = LSE[t * 12 + j]; l1[q] = LSE[t * 12 + 4 + j]; l2[q] = LSE[t * 12 + 8 + j];
                    const bf16* o3 = QA + t * 768 + 4 * lane; a[q] = *(const GAS v2u*)(o3); b[q] = *(const GAS v2u*)(o3 + 256); c[q] = *(const GAS v2u*)(o3 + 512); }
#pragma unroll
                for (int q = 0; q < 8; ++q) { const size_t t = (size_t)pm * 256 + r0 + q * NWAVES;
                    const float mx = fmaxf(l0[q], fmaxf(l1[q], l2[q]));
                    const float e0 = __builtin_amdgcn_exp2f(l0[q] - mx), e1 = __builtin_amdgcn_exp2f(l1[q] - mx), e2 = __builtin_amdgcn_exp2f(l2[q] - mx);
                    const float inv = 1.0f / (e0 + e1 + e2);
                    const f32x4 fa = pg8::bf2_to_f4(a[q].x, a[q].y), fb = pg8::bf2_to_f4(b[q].x, b[q].y), fc = pg8::bf2_to_f4(c[q].x, c[q].y);
                    const f32x4 r = (fa * e0 + fb * e1 + fc * e2) * inv;
                    v2u w; w.x = pk2(r[0], r[1]); w.y = pk2(r[2], r[3]);
                    *(GAS v2u*)(OAB + t * 768 + 4 * lane) = w; }
            }
        }
        VM_WAIT(); __syncthreads();
        pg8::Gemm g{OAB, Wab_t, M, DM, 768}; pg8::PairOrder S{vcu};
        pg8::EpiMerge E{GA, GB, MIX, 4};
        pg8::gemm_phase<pg8::EpiMerge, pg8::PairOrder, true, true>(lds + RING_OFF, g, S, E, wave);
        xcd_barrier(bar);
    }

    for (int rep = 0; rep < REPS(5); ++rep) {
        pg8::Gemm g{MIX, Wo_t, M, DM, DM}; pg8::StaticOrder S; S.init(M, DM, G, bx);
        pg8::EpiOutProj E{x, out, XN, SS};
        pg8::gemm_phase<pg8::EpiOutProj, pg8::StaticOrder, true, true>(lds + RING_OFF, g, S, E, wave);
        xcd_barrier(bar);
    }

    for (int rep = 0; rep < REPS(6); ++rep) {
        pg8::Gemm g{XN, W1_t, M, FF, DM}; pg8::StaticOrder S; S.init(M, FF, G, bx);
        pg8::EpiUp E{SS, HB};
        pg8::gemm_phase<pg8::EpiUp, pg8::StaticOrder, true, true>(lds + RING_OFF, g, S, E, wave);
        xcd_barrier(bar);
    }

    for (int rep = 0; rep < REPS(7); ++rep) {
        const bool dummy = (REPS(7) == 2) && rep == 0;
        pg8::Gemm g{HB, W2_t, M, DM, FF}; pg8::StaticOrder S; S.init(M, DM, G, bx);
        pg8::EpiDown E{out, dummy ? (float*)(ws + WS_GB) : out};
        pg8::gemm_phase<pg8::EpiDown, pg8::StaticOrder, true, true>(lds + RING_OFF, g, S, E, wave);
        if (rep + 1 < REPS(7)) xcd_barrier(bar);
    }
}

extern "C" void kernel_launch(void* const* d_in, const int* in_sizes, int n_in, void* d_out, int out_size, void* d_ws, size_t ws_size, hipStream_t stream) {
    static int grid = 0;
    if (grid == 0) {
        if (n_in != 15 || in_sizes[0] != M * DM || out_size != M * DM || ws_size < WS_END) { fprintf(stderr, "kernel_launch: unexpected shapes (n_in %d in0 %d out %d ws %zu)\n", n_in, n_in > 0 ? in_sizes[0] : -1, out_size, ws_size); grid = -1; return; }
        int dev = 0, cus = 0, per_cu = 0;
        if (hipGetDevice(&dev) != hipSuccess || hipDeviceGetAttribute(&cus, hipDeviceAttributeMultiprocessorCount, dev) != hipSuccess) { grid = -1; return; }
        if (hipFuncSetAttribute((const void*)fwd_megakernel, hipFuncAttributeMaxDynamicSharedMemorySize, LDS_BYTES) != hipSuccess) { fprintf(stderr, "kernel_launch: hipFuncSetAttribute failed\n"); grid = -1; return; }
        if (hipOccupancyMaxActiveBlocksPerMultiprocessor(&per_cu, (const void*)fwd_megakernel, NWAVES * 64, LDS_BYTES) != hipSuccess || per_cu < 1) { fprintf(stderr, "kernel_launch: occupancy query says %d blocks per CU\n", per_cu); (void)hipGetLastError(); grid = -1; return; }
        grid = cus;
    }
    if (grid < 0) return;
    (void)hipMemsetAsync((char*)d_ws + WS_CTL, 0, CTL_ZERO_BYTES, stream);
    Args a{};
    for (int i = 0; i < 15; ++i) a.in[i] = (const float*)d_in[i];
    a.out = (float*)d_out; a.ws = (unsigned char*)d_ws;
    hipLaunchKernelGGL(fwd_megakernel, dim3(grid), dim3(NWAVES * 64), LDS_BYTES, stream, a);
}
```
